# Optimizing an MI355X kernel written in HIP

```python
import jax, jax.numpy as jnp
from jax import lax
import numpy as np

D_MODEL = 2048
BATCH = 1
SEQ = 8192
DEPTH = 1

D_MIX = D_MODEL
D_SSD = D_MIX // 2
SSD_HEAD_DIM = 64
SSD_HEADS = D_SSD // SSD_HEAD_DIM
SSD_GROUPS = 2
SSD_HEADS_PER_GROUP = SSD_HEADS // SSD_GROUPS
SSD_STATE = 128
SSD_CONV = 5
SSD_CHUNK = 128
SSD_CONV_DIM = D_SSD + 2 * SSD_GROUPS * SSD_STATE
D_POOL = D_MIX - D_SSD
POOL_WINDOWS = (2, 4, 8, 16)
POOL_GROUPS = len(POOL_WINDOWS)
POOL_GROUP_DIM = D_POOL // POOL_GROUPS
D_IN_PROJ = D_SSD + SSD_CONV_DIM + 2 * SSD_HEADS + D_POOL
D_FF = 5632
FFN_CONV = 3
D_PLE = 256
EPS = 1e-6

kernel_name = "hybrid_ssd_pool_convglu_encoder_block"

F32 = jnp.float32


def rmsnorm(x, g):
    xf = x.astype(F32)
    y = xf * lax.rsqrt(jnp.mean(xf * xf, axis=-1, keepdims=True) + EPS)
    return (y * g.astype(F32)).astype(x.dtype)


def dwconv_centred(u, w, bias):
    k = w.shape[0]
    L = u.shape[1]
    half = k // 2
    up = jnp.pad(u, ((0, 0), (half, half), (0, 0)))
    wf = w.astype(u.dtype)
    y = up[:, 0:L] * wf[0]
    for j in range(1, k):
        y = y + up[:, j:j + L] * wf[j]
    return y + bias.astype(u.dtype)


def ssd_scan(xs, dt, a, bm, cm):
    b, L, g, e, pdim = xs.shape
    n = bm.shape[-1]
    c = L // SSD_CHUNK
    q = SSD_CHUNK
    xdt = (xs.astype(F32) * dt[..., None]).reshape(b, c, q, g, e, pdim)
    da = jnp.moveaxis((dt * a).reshape(b, c, q, g, e), 2, -1)
    acum = jnp.cumsum(da, axis=-1)
    bmc = bm.astype(F32).reshape(b, c, q, g, n)
    cmc = cm.astype(F32).reshape(b, c, q, g, n)
    causal = jnp.tril(jnp.ones((q, q), dtype=bool))
    seg = acum[..., :, None] - acum[..., None, :]
    decay = jnp.exp(jnp.where(causal, seg, -jnp.inf))
    cb = jnp.einsum("bclgn,bcsgn->bcgls", cmc, bmc)
    y_diag = jnp.einsum("bcgls,bcgels,bcsgep->bclgep", cb, decay, xdt)
    decay_to_end = jnp.exp(acum[..., -1:] - acum)
    states = jnp.einsum("bclgn,bcgel,bclgep->bcgepn", bmc, decay_to_end, xdt)
    chunk_decay = jnp.exp(acum[..., -1])

    def step(h, inp):
        s, d = inp
        return h * d[..., None, None] + s, h

    h0 = jnp.zeros((b, g, e, pdim, n), F32)
    _, h_in = lax.scan(step, h0, (jnp.moveaxis(states, 1, 0), jnp.moveaxis(chunk_decay, 1, 0)))
    h_in = jnp.moveaxis(h_in, 0, 1)
    y_off = jnp.einsum("bclgn,bcgepn,bcgel->bclgep", cmc, h_in, jnp.exp(acum))
    return (y_diag + y_off).reshape(b, L, g, e, pdim)


def ssd_mixer(z, xbc, dt_raw, conv_w, conv_b, dt_bias, a_log, d_skip, norm_w):
    b, L, _ = z.shape
    G, E = SSD_GROUPS, SSD_HEADS_PER_GROUP
    xbc = jax.nn.silu(dwconv_centred(xbc, conv_w, conv_b))
    xs, bm, cm = jnp.split(xbc, [D_SSD, D_SSD + G * SSD_STATE], axis=-1)
    xs = xs.reshape(b, L, G, E, SSD_HEAD_DIM)
    bm = bm.reshape(b, L, G, SSD_STATE)
    cm = cm.reshape(b, L, G, SSD_STATE)
    dt = jax.nn.softplus(dt_raw.astype(F32).reshape(b, L, 2, SSD_HEADS) + dt_bias.astype(F32))
    dt = dt.reshape(b, L, 2, G, E)
    a = (-jnp.exp(a_log.astype(F32))).reshape(2, G, E)
    flip = lambda t: jnp.flip(t, axis=1)
    y_fwd = ssd_scan(xs, dt[:, :, 0], a[0], bm, cm)
    y_bwd = flip(ssd_scan(flip(xs), flip(dt[:, :, 1]), a[1], flip(bm), flip(cm)))
    y = y_fwd + y_bwd + xs.astype(F32) * d_skip.astype(F32).reshape(G, E)[:, :, None]
    y = y.reshape(b, L, D_SSD) * jax.nn.silu(z.astype(F32))
    y = y.reshape(b, L, G, D_SSD // G)
    y = y * lax.rsqrt(jnp.mean(y * y, axis=-1, keepdims=True) + EPS)
    return (y.reshape(b, L, D_SSD) * norm_w.astype(F32)).astype(z.dtype)


def pool_mixer(u, w, scale):
    b, L, _ = u.shape
    uf = u.astype(F32).reshape(b, L, POOL_GROUPS, POOL_GROUP_DIM)
    cs = jnp.concatenate([jnp.zeros((b, 1, POOL_GROUPS, POOL_GROUP_DIM), F32),
                          jnp.cumsum(uf, axis=1)], axis=1)
    t = jnp.arange(L)
    means = []
    for gi, k in enumerate(POOL_WINDOWS):
        lo = jnp.clip(t - k // 2, 0, L)
        hi = jnp.clip(t + (k - k // 2), 0, L)
        csg = cs[:, :, gi]
        cnt = (hi - lo).astype(F32)[None, :, None]
        means.append((csg[:, hi] - csg[:, lo]) / cnt)
    mixed = jnp.stack(means, axis=2) - uf
    y = jnp.einsum("blgc,gcd->blgd", mixed, w.astype(F32))
    return (y.reshape(b, L, D_POOL) * scale.astype(F32)).astype(u.dtype)


def conv_glu(hn, w_up, conv_w, conv_b, w_down):
    up = hn @ w_up
    gate, val = jnp.split(up, 2, axis=-1)
    gate = dwconv_centred(gate, conv_w, conv_b)
    return (jax.nn.gelu(gate, approximate=True) * val) @ w_down


def setup_inputs(seed: int = 0) -> dict:
    key = jax.random.key(seed)
    ks = jax.random.split(key, 24)
    nrm = lambda k, shape, s: jax.random.normal(k, shape, F32) * s
    gain = lambda k: 1.0 + 0.02 * jax.random.normal(k, (DEPTH, D_MODEL), F32)
    dt0 = jnp.exp(jax.random.uniform(ks[6], (DEPTH, 2, SSD_HEADS), F32,
                                     np.log(1e-3).astype(np.float32), np.log(1e-1).astype(np.float32)))
    dt_bias = dt0 + jnp.log(-jnp.expm1(-dt0))
    return {
        "x": jax.random.normal(ks[0], (BATCH, SEQ, D_MODEL), F32),
        "p": jax.random.normal(ks[1], (DEPTH, BATCH, SEQ, D_PLE), F32),
        "mix_norm_pre": gain(ks[2]),
        "mix_norm_post": gain(ks[3]),
        "w_in": nrm(ks[4], (DEPTH, D_MODEL, D_IN_PROJ), D_MODEL ** -0.5),
        "ssd_conv_w": nrm(ks[5], (DEPTH, SSD_CONV, SSD_CONV_DIM), SSD_CONV ** -0.5),
        "ssd_conv_b": nrm(ks[7], (DEPTH, SSD_CONV_DIM), 0.02),
        "ssd_dt_bias": dt_bias,
        "ssd_a_log": jnp.log(jax.random.uniform(ks[8], (DEPTH, 2, SSD_HEADS), F32, 1.0, 16.0)),
        "ssd_d": 1.0 + 0.1 * jax.random.normal(ks[9], (DEPTH, SSD_HEADS), F32),
        "ssd_norm": 1.0 + 0.02 * jax.random.normal(ks[10], (DEPTH, D_SSD), F32),
        "pool_w": nrm(ks[11], (DEPTH, POOL_GROUPS, POOL_GROUP_DIM, POOL_GROUP_DIM), POOL_GROUP_DIM ** -0.5),
        "pool_scale": 1.0 + 0.1 * jax.random.normal(ks[12], (DEPTH, D_POOL), F32),
        "w_out": nrm(ks[13], (DEPTH, D_MIX, D_MODEL), D_MIX ** -0.5),
        "ffn_norm_pre": gain(ks[14]),
        "ffn_norm_post": gain(ks[15]),
        "w_ffn_up": nrm(ks[16], (DEPTH, D_MODEL, 2 * D_FF), D_MODEL ** -0.5),
        "ffn_conv_w": nrm(ks[17], (DEPTH, FFN_CONV, D_FF), FFN_CONV ** -0.5),
        "ffn_conv_b": nrm(ks[18], (DEPTH, D_FF), 0.02),
        "w_ffn_down": nrm(ks[19], (DEPTH, D_FF, D_MODEL), D_FF ** -0.5),
        "ple_norm_pre": gain(ks[20]),
        "w_ple_gate": nrm(ks[21], (DEPTH, D_MODEL, D_MODEL), D_MODEL ** -0.5),
        "w_ple": nrm(ks[22], (DEPTH, D_PLE, D_MODEL), D_PLE ** -0.5),
        "ple_norm_post": gain(ks[23]),
    }


def reference(x, p, mix_norm_pre, mix_norm_post, w_in, ssd_conv_w, ssd_conv_b, ssd_dt_bias,
              ssd_a_log, ssd_d, ssd_norm, pool_w, pool_scale, w_out, ffn_norm_pre, ffn_norm_post,
              w_ffn_up, ffn_conv_w, ffn_conv_b, w_ffn_down, ple_norm_pre, w_ple_gate, w_ple,
              ple_norm_post):
    h = x
    split_at = [D_SSD, D_SSD + SSD_CONV_DIM, D_SSD + SSD_CONV_DIM + 2 * SSD_HEADS]
    for i in range(DEPTH):
        hn = rmsnorm(h, mix_norm_pre[i])
        proj = hn @ w_in[i]
        z, xbc, dt_raw, u = jnp.split(proj, split_at, axis=-1)
        y_ssd = ssd_mixer(z, xbc, dt_raw, ssd_conv_w[i], ssd_conv_b[i], ssd_dt_bias[i],
                          ssd_a_log[i], ssd_d[i], ssd_norm[i])
        y_pool = pool_mixer(u, pool_w[i], pool_scale[i])
        mix = jnp.concatenate([y_ssd, y_pool], axis=-1) @ w_out[i]
        h = h + rmsnorm(mix, mix_norm_post[i])
        hn = rmsnorm(h, ffn_norm_pre[i])
        ff = conv_glu(hn, w_ffn_up[i], ffn_conv_w[i], ffn_conv_b[i], w_ffn_down[i])
        h = h + rmsnorm(ff, ffn_norm_post[i])
        gate = jax.nn.sigmoid(rmsnorm(h, ple_norm_pre[i]) @ w_ple_gate[i])
        h = h + rmsnorm(gate * (p[i] @ w_ple[i]), ple_norm_post[i])
    return h
```

```cpp
#include <hip/hip_runtime.h>
#include <hip/hip_cooperative_groups.h>
#include <cstdio>
#include <cstdint>
namespace cg = cooperative_groups;

namespace pg8 {
#define PG8_LAS __attribute__((address_space(3)))
typedef unsigned short bf16_t;
typedef short bf16x8 __attribute__((ext_vector_type(8)));
typedef float f32x4 __attribute__((ext_vector_type(4)));
typedef unsigned u32x4 __attribute__((ext_vector_type(4)));
typedef unsigned u32x2 __attribute__((ext_vector_type(2)));
constexpr int BM = 256, BK = 64, HALF = 128, HTB = HALF * BK * 2  , STAGE_BYTES = 8 * HTB, NXCD = 8, WGM = 8;

__host__ __device__ __forceinline__ int lds_byte(int r, int c) { const int st = (r >> 4) * 2 + (c >> 5), rr = r & 15, cc = c & 31, ob = rr * 64 + cc * 2; return st * 1024 + (ob ^ (((ob >> 9) & 1) << 5)); }
__host__ __device__ __forceinline__ void stage_rc(int b, int& R, int& C) { const int st = b / 1024, sb = b % 1024, swz = sb ^ (((sb >> 9) & 1) << 5); R = (st >> 1) * 16 + swz / 64; C = (st & 1) * 32 + (swz % 64) / 2; }
__host__ __device__ __forceinline__ int perm32(int rho) { const int n = rho >> 4, i = rho & 15; return 8 * (i >> 2) + 4 * n + (i & 3); }

struct Unit { int pm, pn; };
struct Gemm { const bf16_t* A; const bf16_t* Bt; int lda, ldb, K, a_pn_off;
    __device__ __forceinline__ const char* a_ptr(const Unit& u) const { return (const char*)(A + (size_t)u.pm * BM * lda + (size_t)u.pn * a_pn_off); }
    __device__ __forceinline__ const char* b_ptr(const Unit& u) const { return (const char*)(Bt + (size_t)u.pn * BM * ldb); }
};

struct StaticOrder {
    int nM, nN, nwg, G, c;
    __host__ __device__ void init(int M, int N, int G_, int c_) { nM = M / BM; nN = N / BM; nwg = nM * nN; G = G_; c = c_; }
    __host__ __device__ bool next(int i, Unit& u) const {
        const long L = (long)i * G + c; if (L >= nwg) return false;
        int wgid = (int)L; { const int q = nwg / NXCD, r = nwg % NXCD, xcd = wgid % NXCD, off = wgid / NXCD; wgid = (xcd < r ? xcd * (q + 1) : r * (q + 1) + (xcd - r) * q) + off; }
        const int nig = WGM * nN, gid = wgid / nig, fm = gid * WGM, gsz = (nM - fm) < WGM ? (nM - fm) : WGM;
        u.pm = fm + ((wgid % nig) % gsz); u.pn = (wgid % nig) / gsz; return true;
    }
    __device__ __forceinline__ void a_ready(const Unit&) const {}
    __device__ __forceinline__ void done(const Unit&) const {}
};

__device__ __forceinline__ unsigned cvt_pk_bf16(float lo, float hi) { unsigned r; asm volatile("v_cvt_pk_bf16_f32 %0, %1, %2" : "=v"(r) : "v"(lo), "v"(hi)); return r; }

struct EpiBf16 {
    static constexpr bool PERM = true, AFTER_DRAIN = false;
    bf16_t* O; int ldc;
    __device__ __forceinline__ void operator()(const f32x4 (&acc)[2][2][4][2], const Unit& u, int wr, int wc, int fr, int fq) const {
        const int row0 = u.pm * BM + wr * 64 + fr; const int col0 = u.pn * BM + wc * 32 + 8 * fq;
#pragma unroll
        for (int ai = 0; ai < 2; ++ai)
#pragma unroll
            for (int m = 0; m < 4; ++m) { bf16_t* rowp = O + (size_t)(row0 + ai * HALF + m * 16) * ldc + col0;
#pragma unroll
                for (int bj = 0; bj < 2; ++bj) { const f32x4 v0 = acc[ai][bj][m][0], v1 = acc[ai][bj][m][1];
                    u32x4 w; w.x = cvt_pk_bf16(v0[0], v0[1]); w.y = cvt_pk_bf16(v0[2], v0[3]); w.z = cvt_pk_bf16(v1[0], v1[1]); w.w = cvt_pk_bf16(v1[2], v1[3]);
                    *(u32x4*)(rowp + bj * HALF) = w; } }
    }
};
struct EpiProj {
    static constexpr bool PERM = true, AFTER_DRAIN = false;
    bf16_t* O; float* dtraw;
    __device__ __forceinline__ void operator()(const f32x4 (&acc)[2][2][4][2], const Unit& u, int wr, int wc, int fr, int fq) const {
        const int row0 = u.pm * BM + wr * 64 + fr;
        if (u.pn < 14) { const int col0 = u.pn * BM + wc * 32 + 8 * fq;
#pragma unroll
            for (int ai = 0; ai < 2; ++ai)
#pragma unroll
                for (int m = 0; m < 4; ++m) { bf16_t* rowp = O + (size_t)(row0 + ai * HALF + m * 16) * 3584 + col0;
#pragma unroll
                    for (int bj = 0; bj < 2; ++bj) { const f32x4 v0 = acc[ai][bj][m][0], v1 = acc[ai][bj][m][1];
                        u32x4 w; w.x = cvt_pk_bf16(v0[0], v0[1]); w.y = cvt_pk_bf16(v0[2], v0[3]); w.z = cvt_pk_bf16(v1[0], v1[1]); w.w = cvt_pk_bf16(v1[2], v1[3]);
                        *(u32x4*)(rowp + bj * HALF) = w; } }
        } else if (wc == 0) {
#pragma unroll
            for (int ai = 0; ai < 2; ++ai)
#pragma unroll
                for (int m = 0; m < 4; ++m) { float* rp = dtraw + (size_t)(row0 + ai * HALF + m * 16) * 32 + 8 * fq;
                    *(f32x4*)rp = acc[ai][0][m][0]; *(f32x4*)(rp + 4) = acc[ai][0][m][1]; }
        }
    }
};
struct EpiF32 {
    static constexpr bool PERM = false, AFTER_DRAIN = false;
    float* out; int ldc;
    __device__ __forceinline__ void operator()(const f32x4 (&acc)[2][2][4][2], const Unit& u, int wr, int wc, int fr, int fq) const {
        const int col0 = u.pn * BM + wc * 32 + 4 * fq;
#pragma unroll
        for (int ai = 0; ai < 2; ++ai)
#pragma unroll
            for (int m = 0; m < 4; ++m) { const size_t off = (size_t)(u.pm * BM + ai * HALF + wr * 64 + m * 16 + fr) * ldc + col0;
#pragma unroll
                for (int bj = 0; bj < 2; ++bj)
#pragma unroll
                    for (int n = 0; n < 2; ++n) *(f32x4*)(out + off + bj * HALF + n * 16) = acc[ai][bj][m][n]; }
    }
};
struct EpiGate {
    static constexpr bool PERM = false, AFTER_DRAIN = false;
    float* out; const bf16_t* pp; int ldc;
    __device__ __forceinline__ void operator()(const f32x4 (&acc)[2][2][4][2], const Unit& u, int wr, int wc, int fr, int fq) const {
        const int col0 = u.pn * BM + wc * 32 + 4 * fq;
#pragma unroll
        for (int ai = 0; ai < 2; ++ai)
#pragma unroll
            for (int m = 0; m < 4; ++m) { const size_t off = (size_t)(u.pm * BM + ai * HALF + wr * 64 + m * 16 + fr) * ldc + col0;
#pragma unroll
                for (int bj = 0; bj < 2; ++bj)
#pragma unroll
                    for (int n = 0; n < 2; ++n) { const u32x2 pv = *(const u32x2*)(pp + off + bj * HALF + n * 16); const f32x4 a = acc[ai][bj][m][n]; f32x4 o;
                        o[0] = __uint_as_float(pv.x << 16) / (1.f + __expf(-a[0])); o[1] = __uint_as_float(pv.x & 0xffff0000u) / (1.f + __expf(-a[1]));
                        o[2] = __uint_as_float(pv.y << 16) / (1.f + __expf(-a[2])); o[3] = __uint_as_float(pv.y & 0xffff0000u) / (1.f + __expf(-a[3]));
                        *(f32x4*)(out + off + bj * HALF + n * 16) = o; } }
    }
};

template <class Epi, class Sched, bool ALIGN_EPI = false, bool SP2 = false>
__device__ __forceinline__ void gemm_phase(PG8_LAS unsigned char* lds, const Gemm g, const Sched& S, const Epi& E) {
    const int tid = threadIdx.x, wid = __builtin_amdgcn_readfirstlane(tid >> 6), lane = tid & 63, wr = wid >> 2, wc = wid & 3, fr = lane & 15, fq = lane >> 4;
    const int K = g.K, nt = K / BK;
    unsigned voffA[2], voffB[2];
#pragma unroll
    for (int i = 0; i < 2; ++i) { int R, C; stage_rc(tid * 16 + i * 8192, R, C); const int Rb = Epi::PERM ? ((R & ~31) + perm32(R & 31)) : R;
        voffA[i] = (unsigned)(R * g.lda + C) * 2u; voffB[i] = (unsigned)(Rb * g.ldb + C) * 2u; }
    const size_t kstep = (size_t)(BK * 2);
    const size_t hstepA = (size_t)HALF * g.lda * 2, hstepB = (size_t)HALF * g.ldb * 2;
    const unsigned ldsw = (unsigned)wid * 1024u;
    const int aoff = lds_byte(wr * 64 + fr, fq * 8), boff = lds_byte(wc * 32 + fr, fq * 8);
#define PG8_SA(b, h) (((b) * 2 + (h)) * HTB)
#define PG8_SB(b, h) ((4 + (b) * 2 + (h)) * HTB)
#define PG8_STAGE(bufoff, gbase, voff) do { _Pragma("unroll") for (int _i = 0; _i < 2; ++_i) \
        __builtin_amdgcn_global_load_lds((const unsigned*)((const char*)(gbase) + (voff)[_i]), (PG8_LAS unsigned*)(lds + (bufoff) + ldsw + _i * 8192), 16, 0, 0); } while (0)
#define PG8_LDA(dst, b, h) do { _Pragma("unroll") for (int m = 0; m < 4; ++m) _Pragma("unroll") for (int k = 0; k < 2; ++k) dst[m][k] = *(const PG8_LAS bf16x8*)(lds + PG8_SA(b, h) + aoff + m * 2048 + k * 1024); } while (0)
#define PG8_LDB(dst, b, h) do { _Pragma("unroll") for (int n = 0; n < 2; ++n) _Pragma("unroll") for (int k = 0; k < 2; ++k) dst[n][k] = *(const PG8_LAS bf16x8*)(lds + PG8_SB(b, h) + boff + n * 2048 + k * 1024); } while (0)
#define PG8_MMA(ai, bj, At, Bt) do { __builtin_amdgcn_s_setprio(1); _Pragma("unroll") for (int m = 0; m < 4; ++m) _Pragma("unroll") for (int n = 0; n < 2; ++n) _Pragma("unroll") for (int k = 0; k < 2; ++k) \
        acc[ai][bj][m][n] = __builtin_amdgcn_mfma_f32_16x16x32_bf16(Bt[n][k], At[m][k], acc[ai][bj][m][n], 0, 0, 0); __builtin_amdgcn_s_setprio(0); } while (0)
#define PG8_WAIT_V(n) asm volatile("s_waitcnt vmcnt(" #n ")" ::: "memory")
#define PG8_WAIT_L(n) asm volatile("s_waitcnt lgkmcnt(" #n ")" ::: "memory")
#define PG8_BAR __builtin_amdgcn_s_barrier()
#define PG8_SCHED __builtin_amdgcn_sched_barrier(0)
    Unit cur, nxt; int ui = 0;
    if (!S.next(0, cur)) return;
    f32x4 acc[2][2][4][2];
#pragma unroll
    for (int a = 0; a < 2; ++a)
#pragma unroll
        for (int b = 0; b < 2; ++b)
#pragma unroll
            for (int m = 0; m < 4; ++m)
#pragma unroll
                for (int n = 0; n < 2; ++n) acc[a][b][m][n] = (f32x4){0.f, 0.f, 0.f, 0.f};
    bf16x8 At[4][2], B0[2][2], B1[2][2];
    const char* cA = g.a_ptr(cur); const char* cB = g.b_ptr(cur);
    S.a_ready(cur);
    if constexpr (SP2) {
        PG8_STAGE(PG8_SB(0, 0), cB, voffB); PG8_STAGE(PG8_SB(0, 1), cB + hstepB, voffB); PG8_STAGE(PG8_SA(0, 0), cA, voffA); PG8_STAGE(PG8_SA(0, 1), cA + hstepA, voffA);
        if (wr == 1) PG8_BAR;
        PG8_WAIT_V(2); PG8_BAR;
        PG8_STAGE(PG8_SB(1, 0), cB + kstep, voffB); PG8_STAGE(PG8_SA(1, 0), cA + kstep, voffA); PG8_STAGE(PG8_SB(1, 1), cB + hstepB + kstep, voffB);
        PG8_WAIT_V(6); PG8_BAR;
    } else {
        PG8_STAGE(PG8_SB(0, 0), cB, voffB); PG8_STAGE(PG8_SA(0, 0), cA, voffA); PG8_STAGE(PG8_SB(0, 1), cB + hstepB, voffB); PG8_STAGE(PG8_SA(0, 1), cA + hstepA, voffA);
        if (wr == 1) PG8_BAR;
        PG8_WAIT_V(4); PG8_BAR;
        PG8_STAGE(PG8_SB(1, 0), cB + kstep, voffB); PG8_STAGE(PG8_SA(1, 0), cA + kstep, voffA); PG8_STAGE(PG8_SB(1, 1), cB + hstepB + kstep, voffB);
        PG8_WAIT_V(6); PG8_BAR;
    }
    for (;;) {
        const bool has_next = S.next(ui + 1, nxt);
        const char* nA = has_next ? g.a_ptr(nxt) : cA; const char* nB = has_next ? g.b_ptr(nxt) : cB;
        for (int t = 0; t < nt; t += 2) {
            const bool last = (t == nt - 2);
            const char* a1 = cA + (size_t)(t + 1) * kstep;
            const char* a2 = last ? nA : cA + (size_t)(t + 2) * kstep; const char* b2 = last ? nB : cB + (size_t)(t + 2) * kstep;
            const char* a3 = a2 + kstep; const char* b3 = b2 + kstep;
            if (last && has_next) S.a_ready(nxt);
            if constexpr (SP2) {
            PG8_LDB(B0, 0, 0); PG8_LDB(B1, 0, 1); PG8_SCHED; PG8_LDA(At, 0, 0); PG8_STAGE(PG8_SA(1, 1), a1 + hstepA, voffA);
            PG8_WAIT_V(8); PG8_WAIT_L(0); PG8_BAR; PG8_MMA(0, 0, At, B0); PG8_MMA(0, 1, At, B1); PG8_BAR; PG8_SCHED;
            PG8_LDA(At, 0, 1); PG8_STAGE(PG8_SB(0, 0), b2, voffB); PG8_STAGE(PG8_SB(0, 1), b2 + hstepB, voffB); PG8_STAGE(PG8_SA(0, 0), a2, voffA);
            PG8_WAIT_V(8); PG8_WAIT_L(0); PG8_BAR; PG8_MMA(1, 0, At, B0); PG8_MMA(1, 1, At, B1); PG8_BAR; PG8_SCHED;
            PG8_LDB(B0, 1, 0); PG8_LDB(B1, 1, 1); PG8_SCHED; PG8_LDA(At, 1, 0); PG8_STAGE(PG8_SA(0, 1), a2 + hstepA, voffA);
            PG8_WAIT_V(8); PG8_WAIT_L(0); PG8_BAR; PG8_MMA(0, 0, At, B0); PG8_MMA(0, 1, At, B1); PG8_BAR; PG8_SCHED;
            PG8_LDA(At, 1, 1); PG8_STAGE(PG8_SB(1, 0), b3, voffB); PG8_STAGE(PG8_SB(1, 1), b3 + hstepB, voffB); PG8_STAGE(PG8_SA(1, 0), a3, voffA);
            PG8_WAIT_V(8); PG8_WAIT_L(0); PG8_BAR; PG8_MMA(1, 0, At, B0); PG8_MMA(1, 1, At, B1); PG8_BAR; PG8_SCHED;
            } else {
            PG8_LDB(B0, 0, 0); PG8_SCHED; PG8_LDA(At, 0, 0); PG8_STAGE(PG8_SA(1, 1), a1 + hstepA, voffA);
            PG8_WAIT_L(8); PG8_BAR; PG8_WAIT_L(0); PG8_MMA(0, 0, At, B0); PG8_BAR; PG8_SCHED;
            PG8_LDB(B1, 0, 1); PG8_STAGE(PG8_SB(0, 0), b2, voffB);
            PG8_BAR; PG8_WAIT_L(0); PG8_MMA(0, 1, At, B1); PG8_BAR;
            PG8_LDA(At, 0, 1); PG8_STAGE(PG8_SA(0, 0), a2, voffA);
            PG8_BAR; PG8_WAIT_L(0); PG8_MMA(1, 0, At, B0); PG8_BAR; PG8_SCHED;
            PG8_STAGE(PG8_SB(0, 1), b2 + hstepB, voffB);
            PG8_WAIT_V(6); PG8_BAR; PG8_MMA(1, 1, At, B1); PG8_BAR;
            PG8_LDB(B0, 1, 0); PG8_SCHED; PG8_LDA(At, 1, 0); PG8_STAGE(PG8_SA(0, 1), a2 + hstepA, voffA);
            PG8_WAIT_L(8); PG8_BAR; PG8_WAIT_L(0); PG8_MMA(0, 0, At, B0); PG8_BAR; PG8_SCHED;
            PG8_LDB(B1, 1, 1); PG8_STAGE(PG8_SB(1, 0), b3, voffB);
            PG8_BAR; PG8_WAIT_L(0); PG8_MMA(0, 1, At, B1); PG8_BAR;
            PG8_LDA(At, 1, 1); PG8_STAGE(PG8_SA(1, 0), a3, voffA);
            PG8_BAR; PG8_WAIT_L(0); PG8_MMA(1, 0, At, B0); PG8_BAR; PG8_SCHED;
            PG8_STAGE(PG8_SB(1, 1), b3 + hstepB, voffB);
            PG8_WAIT_V(6); PG8_BAR; PG8_MMA(1, 1, At, B1); PG8_BAR;
            }
        }
        if constexpr (ALIGN_EPI) { if (wr == 0) PG8_BAR; }
        if constexpr (!Epi::AFTER_DRAIN) { E(acc, cur, wr, wc, fr, fq); S.done(cur); }
        if (!has_next) break;
#pragma unroll
        for (int a = 0; a < 2; ++a)
#pragma unroll
            for (int b = 0; b < 2; ++b)
#pragma unroll
                for (int m = 0; m < 4; ++m)
#pragma unroll
                    for (int n = 0; n < 2; ++n) acc[a][b][m][n] = (f32x4){0.f, 0.f, 0.f, 0.f};
        cur = nxt; cA = nA; cB = nB; ++ui;
        if constexpr (ALIGN_EPI) { if (wr == 1) PG8_BAR; }
    }
    PG8_WAIT_V(0);
    if constexpr (!ALIGN_EPI) { if (wr == 0) PG8_BAR; }
    PG8_BAR;
    if constexpr (Epi::AFTER_DRAIN) { E.fused(acc, cur, wr, wc, fr, fq, lds, wid, lane); S.done(cur); }
#undef PG8_SA
#undef PG8_SB
#undef PG8_STAGE
#undef PG8_LDA
#undef PG8_LDB
#undef PG8_MMA
#undef PG8_WAIT_V
#undef PG8_WAIT_L
#undef PG8_BAR
#undef PG8_SCHED
}
}

constexpr int NWAVES = 8;
constexpr int L = 8192, DM = 2048, DSSD = 1024, NH = 16, NCH = 64  , DFF = 5632, DPLE = 256;
constexpr int NPROJ = 3584;
constexpr int NPROJ_PAD = 3840;
constexpr float EPS = 1e-6f;
#ifndef MK_N_LAUNCHES
#define MK_N_LAUNCHES 1
#endif
constexpr int N_PHASES = 14;

constexpr size_t MiB = 1u << 20;
constexpr size_t WS_WDOWN = 1 * MiB, WS_WUP = 23 * MiB, WS_HN = 67 * MiB, WS_PP = 99 * MiB, WS_WGATE = 131 * MiB, WS_WPLE = 139 * MiB, WS_WPOOL = 140 * MiB;
constexpr size_t WS_UP = 141 * MiB;
constexpr size_t WS_WIN = 141 * MiB, WS_WOUT = 156 * MiB, WS_PROJ = 164 * MiB, WS_YCAT = 224 * MiB, WS_MIXED = 256 * MiB, WS_XST = 272 * MiB;
constexpr size_t WS_BM = 288 * MiB, WS_BMT = 292 * MiB, WS_CM = 296 * MiB, WS_TAB = 300 * MiB, WS_DTRAW = 302 * MiB, WS_HIN = 304 * MiB, WS_PBF = 336 * MiB;
constexpr size_t WS_STATES = 67 * MiB;
constexpr size_t WS_MIX = 256 * MiB;
constexpr size_t WS_FF = 23 * MiB;
constexpr size_t WS_HN3 = 141 * MiB, WS_T = 173 * MiB;
constexpr size_t WS_END = 340 * MiB;

constexpr int LDS_BYTES = 155648;

#define LAS __attribute__((address_space(3)))
typedef unsigned short bf16;
typedef unsigned v4u __attribute__((ext_vector_type(4)));
typedef unsigned v2u __attribute__((ext_vector_type(2)));
typedef float f32x4 __attribute__((ext_vector_type(4)));
typedef float f32x2 __attribute__((ext_vector_type(2)));
typedef short bf16x8 __attribute__((ext_vector_type(8)));
#define LDS_WAIT() asm volatile("s_waitcnt lgkmcnt(0)" ::: "memory")
__device__ __forceinline__ unsigned f2bf(float f) { unsigned u = __builtin_bit_cast(unsigned, f); return (u + 0x7fffu + ((u >> 16) & 1u)) >> 16; }
__device__ __forceinline__ unsigned pk2(float lo, float hi) { return f2bf(lo) | (f2bf(hi) << 16); }
__device__ __forceinline__ float bf2f(bf16 b) { return __uint_as_float((unsigned)b << 16); }
__device__ __forceinline__ float bflo(unsigned u) { return __uint_as_float(u << 16); }
__device__ __forceinline__ float bfhi(unsigned u) { return __uint_as_float(u & 0xffff0000u); }
__device__ __forceinline__ float wave_sum(float v) {
#pragma unroll
    for (int o = 1; o < 64; o <<= 1) v += __shfl_xor(v, o);
    return v;
}
__device__ __forceinline__ float dot4(f32x4 a) { return (a.x * a.x + a.y * a.y) + (a.z * a.z + a.w * a.w); }

struct Ptrs {
    const float *x, *p, *mix_norm_pre, *mix_norm_post, *w_in, *ssd_conv_w, *ssd_conv_b, *ssd_dt_bias, *ssd_a_log, *ssd_d, *ssd_norm, *pool_w, *pool_scale, *w_out,
        *ffn_norm_pre, *ffn_norm_post, *w_ffn_up, *ffn_conv_w, *ffn_conv_b, *w_ffn_down, *ple_norm_pre, *w_ple_gate, *w_ple, *ple_norm_post;
    float* out; unsigned char* ws;
};

__device__ __forceinline__ void p0_transpose_item(const float* W, int N, bf16* WT, int ldt, int drow0, int k0, int n0, const float* scale, LAS float* scr, int lane) {
#pragma unroll 8
    for (int i = 0; i < 32; ++i) { const int kk = 2 * i + (lane >> 5); scr[kk * 33 + (lane & 31)] = W[(size_t)(k0 + kk) * N + n0 + (lane & 31)]; }
    LDS_WAIT(); asm volatile("" ::: "memory");
    const int c = lane & 7;
#pragma unroll
    for (int j = 0; j < 4; ++j) { const int n = (lane >> 3) + 8 * j; const LAS float* s = scr + (8 * c) * 33 + n; const float sc = scale ? scale[n0 + n] : 1.f;
        v4u o; o.x = pk2(s[0 * 33] * sc, s[1 * 33] * sc); o.y = pk2(s[2 * 33] * sc, s[3 * 33] * sc); o.z = pk2(s[4 * 33] * sc, s[5 * 33] * sc); o.w = pk2(s[6 * 33] * sc, s[7 * 33] * sc);
        *(v4u*)(WT + (size_t)(drow0 + n) * ldt + k0 + 8 * c) = o; }
    LDS_WAIT(); asm volatile("" ::: "memory");
}
__device__ __forceinline__ void rms_row_to_bf16(const float* xrow, const float* g, bf16* orow, int lane) {
    const f32x4* xr = (const f32x4*)xrow + lane; f32x4 v[8]; float s = 0.f;
#pragma unroll
    for (int j = 0; j < 8; ++j) { v[j] = xr[64 * j]; s += dot4(v[j]); }
    const float r = 1.f / sqrtf(wave_sum(s) * (1.f / DM) + EPS);
#pragma unroll
    for (int j = 0; j < 8; ++j) { const f32x4 gv = ((const f32x4*)g)[lane + 64 * j]; const f32x4 o = v[j] * r * gv;
        *(v2u*)(orow + (size_t)(lane + 64 * j) * 4) = (v2u){pk2(o.x, o.y), pk2(o.z, o.w)}; }
}
__device__ __forceinline__ void p0_prologue(const Ptrs& P, LAS unsigned char* lds, int G, int wave, int lane) {
    LAS float* scr = (LAS float*)(lds + wave * 16384);
    const int gw = blockIdx.x * NWAVES + wave, NGW = G * NWAVES;
    bf16* w_inT = (bf16*)(P.ws + WS_WIN); bf16* w_outT = (bf16*)(P.ws + WS_WOUT); bf16* w_upT = (bf16*)(P.ws + WS_WUP); bf16* w_downT = (bf16*)(P.ws + WS_WDOWN);
    bf16* w_gateT = (bf16*)(P.ws + WS_WGATE); bf16* w_pleT = (bf16*)(P.ws + WS_WPLE); bf16* w_poolT = (bf16*)(P.ws + WS_WPOOL);
    constexpr int I_IN = 32 * 113, I_OUT = 32 * 64, I_UP = 32 * 352, I_DOWN = 88 * 64, I_GATE = 32 * 64, I_PLE = 4 * 64, I_POOL = 4 * 32;
    constexpr int NITEMS = I_IN + I_OUT + I_UP + I_DOWN + I_GATE + I_PLE + I_POOL;
    for (int it = gw; it < NITEMS; it += NGW) {
        int r = it;
        if (r < I_IN) { const int kb = r / 113, nb = r % 113; const int drow = nb < 80 ? nb * 32 : (nb == 80 ? 3584 : (nb - 1) * 32);
            p0_transpose_item(P.w_in, 3616, w_inT, DM, drow, kb * 64, nb * 32, nullptr, scr, lane); continue; } r -= I_IN;
        if (r < I_OUT) { const int kb = r / 64, nb = r % 64; p0_transpose_item(P.w_out, DM, w_outT, DM, nb * 32, kb * 64, nb * 32, nullptr, scr, lane); continue; } r -= I_OUT;
        if (r < I_UP) { const int kb = r / 352, nb = r % 352; p0_transpose_item(P.w_ffn_up, 2 * DFF, w_upT, DM, nb * 32, kb * 64, nb * 32, nullptr, scr, lane); continue; } r -= I_UP;
        if (r < I_DOWN) { const int kb = r / 64, nb = r % 64; p0_transpose_item(P.w_ffn_down, DM, w_downT, DFF, nb * 32, kb * 64, nb * 32, nullptr, scr, lane); continue; } r -= I_DOWN;
        if (r < I_GATE) { const int kb = r / 64, nb = r % 64; p0_transpose_item(P.w_ple_gate, DM, w_gateT, DM, nb * 32, kb * 64, nb * 32, nullptr, scr, lane); continue; } r -= I_GATE;
        if (r < I_PLE) { const int kb = r / 64, nb = r % 64; p0_transpose_item(P.w_ple, DM, w_pleT, DPLE, nb * 32, kb * 64, nb * 32, nullptr, scr, lane); continue; } r -= I_PLE;
        { const int gi = r / 32, q = r % 32, kb = q / 8, nb = q % 8;
          p0_transpose_item(P.pool_w + (size_t)gi * 65536, 256, w_poolT + (size_t)gi * 65536, 256, nb * 32, kb * 64, nb * 32, P.pool_scale + gi * 256, scr, lane); }
    }
    { v4u* zp = (v4u*)(w_inT + (size_t)3616 * DM); const int nz = 224 * DM * 2 / 16;
      for (int i = gw * 64 + lane; i < nz; i += NGW * 64) zp[i] = (v4u){0u, 0u, 0u, 0u}; }
    { const f32x4* ps = (const f32x4*)P.p; v2u* pd = (v2u*)(P.ws + WS_PBF); const int np = L * DPLE / 4;
      for (int i = gw * 64 + lane; i < np; i += NGW * 64) { const f32x4 v = ps[i]; pd[i] = (v2u){pk2(v.x, v.y), pk2(v.z, v.w)}; } }
    bf16* hn = (bf16*)(P.ws + WS_HN);
    for (int m = gw; m < L; m += NGW) rms_row_to_bf16(P.x + (size_t)m * DM, P.mix_norm_pre, hn + (size_t)m * DM, lane);
}

__device__ __forceinline__ float softplus_f(float x) { return fmaxf(x, 0.f) + log1pf(__expf(-fabsf(x))); }
template <int K> __device__ __forceinline__ void pool_item(const bf16* src, bf16* dst, int t0) {
    constexpr int H = K / 2, NR = 8 + K - 1;
    float v[NR];
#pragma unroll
    for (int r = 0; r < NR; ++r) { const int t = t0 - H + r; v[r] = (t >= 0 && t < L) ? bf2f(src[(size_t)t * NPROJ]) : 0.f; }
#pragma unroll
    for (int i = 0; i < 8; ++i) { const int t = t0 + i; const int lo = t - H > 0 ? t - H : 0, hi = t + H < L ? t + H : L; float s = 0.f;
#pragma unroll
        for (int r = 0; r < K; ++r) s += v[i + r];
        const float o = s / (float)(hi - lo) - v[i + H]; dst[(size_t)t * 1024] = (bf16)f2bf(o); }
}
__device__ __forceinline__ void p2_phase(const Ptrs& P, int G, int wave, int lane) {
    const int gw = blockIdx.x * NWAVES + wave, NGW = G * NWAVES;
    const bf16* proj = (const bf16*)(P.ws + WS_PROJ); const float* dtraw = (const float*)(P.ws + WS_DTRAW); float* tab = (float*)(P.ws + WS_TAB);
    bf16* xsT = (bf16*)(P.ws + WS_XST); bf16* Bm = (bf16*)(P.ws + WS_BM); bf16* BmT = (bf16*)(P.ws + WS_BMT); bf16* Cm = (bf16*)(P.ws + WS_CM); bf16* mixed = (bf16*)(P.ws + WS_MIXED);
    for (int id = gw; id < NCH * 2 * NH; id += NGW) {
        const int c = id >> 5, dir = (id >> 4) & 1, h = id & 15;
        const float bias = P.ssd_dt_bias[dir * NH + h], a = -__expf(P.ssd_a_log[dir * NH + h]);
        const int i0 = 2 * lane, i1 = 2 * lane + 1, l0 = dir ? 127 - i0 : i0, l1 = dir ? 127 - i1 : i1;
        const float dt0 = softplus_f(dtraw[(size_t)(c * 128 + l0) * 32 + dir * NH + h] + bias), dt1 = softplus_f(dtraw[(size_t)(c * 128 + l1) * 32 + dir * NH + h] + bias);
        const float da0 = dt0 * a, da1 = dt1 * a; float s = da0 + da1;
#pragma unroll
        for (int o = 1; o < 64; o <<= 1) { const float t = __shfl_up(s, o); if (lane >= o) s += t; }
        const float excl = s - (da0 + da1);
        float* ta = tab + ((size_t)(dir * NCH + c) * NH + h) * 128; float* td = tab + ((size_t)((2 + dir) * NCH + c) * NH + h) * 128;
        ta[l0] = excl + da0; ta[l1] = s; td[l0] = dt0; td[l1] = dt1;
    }
    for (int it = gw; it < 1024 * 24; it += NGW) {
        const int tb = it / 24, cb = it % 24, t0 = tb * 8, ch = cb * 64 + lane;
        const bf16* src = proj + 1024 + ch; float v[12];
#pragma unroll
        for (int r = 0; r < 12; ++r) { const int t = t0 - 2 + r; v[r] = (t >= 0 && t < L) ? bf2f(src[(size_t)t * NPROJ]) : 0.f; }
        float w[5];
#pragma unroll
        for (int j = 0; j < 5; ++j) w[j] = P.ssd_conv_w[j * 1536 + ch];
        const float b = P.ssd_conv_b[ch]; float o[8];
#pragma unroll
        for (int i = 0; i < 8; ++i) { float a = b;
#pragma unroll
            for (int j = 0; j < 5; ++j) a += w[j] * v[i + j];
            o[i] = a / (1.f + __expf(-a)); }
        const v4u pk = (v4u){pk2(o[0], o[1]), pk2(o[2], o[3]), pk2(o[4], o[5]), pk2(o[6], o[7])};
        const int c = t0 >> 7, l0 = t0 & 127;
        if (cb < 16) {
            *(v4u*)(xsT + ((size_t)((c * NH + cb) * 64 + lane)) * 128 + l0) = pk;
        } else if (cb < 20) {
            const int gn = ch - 1024, g = gn >> 7, n = gn & 127;
            *(v4u*)(BmT + ((size_t)((c * 2 + g) * 128 + n)) * 128 + l0) = pk;
#pragma unroll
            for (int i = 0; i < 8; ++i) Bm[(size_t)(t0 + i) * 256 + gn] = (bf16)f2bf(o[i]);
        } else {
            const int cn = ch - 1280;
#pragma unroll
            for (int i = 0; i < 8; ++i) Cm[(size_t)(t0 + i) * 256 + cn] = (bf16)f2bf(o[i]);
        }
    }
    for (int it = gw; it < 1024 * 16; it += NGW) {
        const int tb = it >> 4, cb = it & 15, t0 = tb * 8, ch = cb * 64 + lane, gi = cb >> 2;
        const bf16* src = proj + 2560 + ch; bf16* dst = mixed + ch;
        if (gi == 0) pool_item<2>(src, dst, t0); else if (gi == 1) pool_item<4>(src, dst, t0); else if (gi == 2) pool_item<8>(src, dst, t0); else pool_item<16>(src, dst, t0);
    }
}

__device__ __forceinline__ void p3_phase(const Ptrs& P, int G, int wave, int lane) {
    const int gw = blockIdx.x * NWAVES + wave, NGW = G * NWAVES, fr = lane & 15, fq = lane >> 4;
    const float* tab = (const float*)(P.ws + WS_TAB); const bf16* xsT = (const bf16*)(P.ws + WS_XST); const bf16* BmT = (const bf16*)(P.ws + WS_BMT); float* states = (float*)(P.ws + WS_STATES);
    for (int id = gw; id < NCH * 2 * NH; id += NGW) {
        const int c = id >> 5, dir = (id >> 4) & 1, h = id & 15, g = h >> 3;
        const float* ta = tab + ((size_t)(dir * NCH + c) * NH + h) * 128; const float* td = tab + ((size_t)((2 + dir) * NCH + c) * NH + h) * 128;
        const float a_end = dir ? ta[0] : ta[127];
        f32x4 acc[4][8];
#pragma unroll
        for (int mt = 0; mt < 4; ++mt)
#pragma unroll
            for (int nt = 0; nt < 8; ++nt) acc[mt][nt] = (f32x4){0.f, 0.f, 0.f, 0.f};
#pragma unroll 1
        for (int kk = 0; kk < 4; ++kk) {
            const int lb = kk * 32 + fq * 8;
            const f32x4 a0 = *(const f32x4*)(ta + lb), a1 = *(const f32x4*)(ta + lb + 4), d0 = *(const f32x4*)(td + lb), d1 = *(const f32x4*)(td + lb + 4);
            float w[8];
#pragma unroll
            for (int i = 0; i < 4; ++i) { w[i] = d0[i] * __expf(a_end - a0[i]); w[4 + i] = d1[i] * __expf(a_end - a1[i]); }
            bf16x8 Af[4];
#pragma unroll
            for (int mt = 0; mt < 4; ++mt) { const v4u raw = *(const v4u*)(xsT + ((size_t)((c * NH + h) * 64 + mt * 16 + fr)) * 128 + lb);
                v4u sc; sc.x = pk2(bflo(raw.x) * w[0], bfhi(raw.x) * w[1]); sc.y = pk2(bflo(raw.y) * w[2], bfhi(raw.y) * w[3]);
                sc.z = pk2(bflo(raw.z) * w[4], bfhi(raw.z) * w[5]); sc.w = pk2(bflo(raw.w) * w[6], bfhi(raw.w) * w[7]);
                Af[mt] = __builtin_bit_cast(bf16x8, sc); }
#pragma unroll
            for (int nt = 0; nt < 8; ++nt) { const bf16x8 Bf = *(const bf16x8*)(BmT + ((size_t)((c * 2 + g) * 128 + nt * 16 + fr)) * 128 + lb);
#pragma unroll
                for (int mt = 0; mt < 4; ++mt) acc[mt][nt] = __builtin_amdgcn_mfma_f32_16x16x32_bf16(Bf, Af[mt], acc[mt][nt], 0, 0, 0); }
        }
        float* so = states + ((size_t)((dir * NCH + c) * NH + h)) * 64 * 128;
#pragma unroll
        for (int mt = 0; mt < 4; ++mt)
#pragma unroll
            for (int nt = 0; nt < 8; ++nt) *(f32x4*)(so + (size_t)(mt * 16 + fr) * 128 + nt * 16 + fq * 4) = acc[mt][nt];
    }
}

__device__ __forceinline__ void p4_phase(const Ptrs& P, int G) {
    const float* tab = (const float*)(P.ws + WS_TAB); const float* states = (const float*)(P.ws + WS_STATES); bf16* hin = (bf16*)(P.ws + WS_HIN);
    for (int e = blockIdx.x * 512 + threadIdx.x; e < 2 * NH * 64 * 64; e += G * 512) {
        const int n2 = e & 63, p = (e >> 6) & 63, h = (e >> 12) & 15, dir = e >> 16;
        const size_t eo = (size_t)p * 128 + 2 * n2, cstride = (size_t)NH * 64 * 128;
        const float* sb = states + ((size_t)(dir * NCH) * NH + h) * 64 * 128 + eo; bf16* hb = hin + ((size_t)(dir * NCH) * NH + h) * 64 * 128 + eo;
        const float* ta = tab + ((size_t)(dir * NCH) * NH + h) * 128 + (dir ? 0 : 127);
        f32x2 st = (f32x2){0.f, 0.f};
#pragma unroll 1
        for (int i0 = 0; i0 < NCH; i0 += 8) {
            f32x2 sv[8]; float cd[8];
#pragma unroll
            for (int j = 0; j < 8; ++j) { const int c = dir ? NCH - 1 - (i0 + j) : i0 + j; sv[j] = *(const f32x2*)(sb + (size_t)c * cstride); cd[j] = ta[(size_t)c * NH * 128]; }
#pragma unroll
            for (int j = 0; j < 8; ++j) { const int c = dir ? NCH - 1 - (i0 + j) : i0 + j;
                *(unsigned*)(hb + (size_t)c * cstride) = pk2(st.x, st.y);
                const float d = __expf(cd[j]); st = st * d + sv[j]; }
        }
    }
}

__device__ __forceinline__ void p5_ssd_unit(const Ptrs& P, LAS unsigned char* lds, int c, int g, int tid, int wave, int lane) {
    const int fr = lane & 15, fq = lane >> 4;
    const float* tab = (const float*)(P.ws + WS_TAB); const bf16* xsT = (const bf16*)(P.ws + WS_XST); const bf16* Bm = (const bf16*)(P.ws + WS_BM); const bf16* Cm = (const bf16*)(P.ws + WS_CM);
    const bf16* hin = (const bf16*)(P.ws + WS_HIN); const bf16* proj = (const bf16*)(P.ws + WS_PROJ); bf16* ycat = (bf16*)(P.ws + WS_YCAT);
    LAS float* T = (LAS float*)lds;
    LAS v2u* ybuf = (LAS v2u*)(lds + 16384 + wave * 16384);
    __syncthreads();
    for (int idx = tid; idx < 4 * 8 * 128; idx += 512) { const int which = idx >> 10, hh = (idx >> 7) & 7, l = idx & 127; T[idx] = tab[((size_t)(which * NCH + c) * NH + g * 8 + hh) * 128 + l]; }
    __syncthreads();
    const int t0 = c * 128, lrow = wave * 16 + fr;
    bf16x8 Cf[4];
#pragma unroll
    for (int kk = 0; kk < 4; ++kk) Cf[kk] = *(const bf16x8*)(Cm + (size_t)(t0 + lrow) * 256 + g * 128 + kk * 32 + fq * 8);
    f32x4 cb[8];
#pragma unroll
    for (int st = 0; st < 8; ++st) { cb[st] = (f32x4){0.f, 0.f, 0.f, 0.f};
#pragma unroll
        for (int kk = 0; kk < 4; ++kk) { const bf16x8 Bf = *(const bf16x8*)(Bm + (size_t)(t0 + st * 16 + fr) * 256 + g * 128 + kk * 32 + fq * 8);
            cb[st] = __builtin_amdgcn_mfma_f32_16x16x32_bf16(Bf, Cf[kk], cb[st], 0, 0, 0); } }
    float sumsq = 0.f;
#pragma unroll 1
    for (int hh = 0; hh < 8; ++hh) {
        const int h = g * 8 + hh;
        const float alf = T[(0 * 8 + hh) * 128 + lrow], alb = T[(1 * 8 + hh) * 128 + lrow], dsk = P.ssd_d[h];
        bf16x8 Mf[4];
#pragma unroll
        for (int kk = 0; kk < 4; ++kk) { float mv[8];
#pragma unroll
            for (int hf = 0; hf < 2; ++hf) { const int st = 2 * kk + hf, s0 = st * 16 + fq * 4;
                const f32x4 asf = *(const LAS f32x4*)(T + (0 * 8 + hh) * 128 + s0), asb = *(const LAS f32x4*)(T + (1 * 8 + hh) * 128 + s0);
                const f32x4 dsf = *(const LAS f32x4*)(T + (2 * 8 + hh) * 128 + s0), dsb = *(const LAS f32x4*)(T + (3 * 8 + hh) * 128 + s0);
#pragma unroll
                for (int r = 0; r < 4; ++r) { const int s = s0 + r;
                    const float vf = (s <= lrow) ? __expf(fminf(alf - asf[r], 0.f)) * dsf[r] : 0.f;
                    const float vb = (s >= lrow) ? __expf(fminf(alb - asb[r], 0.f)) * dsb[r] : 0.f;
                    mv[hf * 4 + r] = cb[st][r] * (vf + vb) + ((s == lrow) ? dsk : 0.f); } }
            const v4u pk = (v4u){pk2(mv[0], mv[1]), pk2(mv[2], mv[3]), pk2(mv[4], mv[5]), pk2(mv[6], mv[7])};
            Mf[kk] = __builtin_bit_cast(bf16x8, pk); }
        f32x4 accY[4], accF[4], accB[4];
#pragma unroll
        for (int pt = 0; pt < 4; ++pt) { accY[pt] = (f32x4){0.f, 0.f, 0.f, 0.f}; accF[pt] = accY[pt]; accB[pt] = accY[pt]; }
        const bf16* xh = xsT + ((size_t)(c * NH + h) * 64) * 128;
        const bf16* hf_ = hin + ((size_t)((0 * NCH + c) * NH + h) * 64) * 128; const bf16* hb_ = hin + ((size_t)((1 * NCH + c) * NH + h) * 64) * 128;
#pragma unroll
        for (int kk = 0; kk < 4; ++kk)
#pragma unroll
            for (int pt = 0; pt < 4; ++pt) { const bf16* xr = xh + (size_t)(pt * 16 + fr) * 128;
                const v2u lo = *(const v2u*)(xr + (2 * kk) * 16 + fq * 4), hi = *(const v2u*)(xr + (2 * kk + 1) * 16 + fq * 4);
                const bf16x8 Xf = __builtin_bit_cast(bf16x8, ((v4u){lo.x, lo.y, hi.x, hi.y}));
                accY[pt] = __builtin_amdgcn_mfma_f32_16x16x32_bf16(Xf, Mf[kk], accY[pt], 0, 0, 0);
                const bf16x8 Hf = *(const bf16x8*)(hf_ + (size_t)(pt * 16 + fr) * 128 + kk * 32 + fq * 8);
                accF[pt] = __builtin_amdgcn_mfma_f32_16x16x32_bf16(Hf, Cf[kk], accF[pt], 0, 0, 0);
                const bf16x8 Hb = *(const bf16x8*)(hb_ + (size_t)(pt * 16 + fr) * 128 + kk * 32 + fq * 8);
                accB[pt] = __builtin_amdgcn_mfma_f32_16x16x32_bf16(Hb, Cf[kk], accB[pt], 0, 0, 0); }
        const float ef = __expf(alf), eb = __expf(alb);
#pragma unroll
        for (int pt = 0; pt < 4; ++pt) {
            const v2u zr = *(const v2u*)(proj + (size_t)(t0 + lrow) * NPROJ + h * 64 + pt * 16 + fq * 4);
            const float z[4] = {bflo(zr.x), bfhi(zr.x), bflo(zr.y), bfhi(zr.y)}; float y[4];
#pragma unroll
            for (int r = 0; r < 4; ++r) { y[r] = (accY[pt][r] + ef * accF[pt][r] + eb * accB[pt][r]) * (z[r] / (1.f + __expf(-z[r]))); sumsq += y[r] * y[r]; }
            ybuf[(hh * 4 + pt) * 64 + lane] = (v2u){pk2(y[0], y[1]), pk2(y[2], y[3])}; }
    }
    sumsq += __shfl_xor(sumsq, 16); sumsq += __shfl_xor(sumsq, 32);
    const float rs = 1.f / sqrtf(sumsq * (1.f / 512.f) + EPS);
    LDS_WAIT();
#pragma unroll
    for (int hh = 0; hh < 8; ++hh)
#pragma unroll
        for (int pt = 0; pt < 4; ++pt) { const v2u yv = ybuf[(hh * 4 + pt) * 64 + lane]; const int ch = g * 512 + hh * 64 + pt * 16 + fq * 4; const f32x4 nw = *(const f32x4*)(P.ssd_norm + ch);
            *(v2u*)(ycat + (size_t)(t0 + lrow) * DM + ch) = (v2u){pk2(bflo(yv.x) * rs * nw.x, bfhi(yv.x) * rs * nw.y), pk2(bflo(yv.y) * rs * nw.z, bfhi(yv.y) * rs * nw.w)}; }
}

__device__ __forceinline__ void res_norm_norm_row(const float* m, const float* hin, float* hout, const float* g1, const float* g2, bf16* hn, int lane) {
    f32x4 v[8]; float s = 0.f;
#pragma unroll
    for (int j = 0; j < 8; ++j) { v[j] = ((const f32x4*)m)[lane + 64 * j]; s += dot4(v[j]); }
    const float r1 = 1.f / sqrtf(wave_sum(s) * (1.f / DM) + EPS); float s2 = 0.f;
#pragma unroll
    for (int j = 0; j < 8; ++j) { const f32x4 gv = ((const f32x4*)g1)[lane + 64 * j], hv = ((const f32x4*)hin)[lane + 64 * j]; v[j] = hv + v[j] * r1 * gv; s2 += dot4(v[j]); ((f32x4*)hout)[lane + 64 * j] = v[j]; }
    const float r2 = 1.f / sqrtf(wave_sum(s2) * (1.f / DM) + EPS);
#pragma unroll
    for (int j = 0; j < 8; ++j) { const f32x4 gv = ((const f32x4*)g2)[lane + 64 * j]; const f32x4 o = v[j] * r2 * gv; *(v2u*)(hn + (size_t)(lane + 64 * j) * 4) = (v2u){pk2(o.x, o.y), pk2(o.z, o.w)}; }
}
__device__ __forceinline__ void res_norm_row(const float* m, const float* hin, float* hout, const float* g1, int lane) {
    f32x4 v[8]; float s = 0.f;
#pragma unroll
    for (int j = 0; j < 8; ++j) { v[j] = ((const f32x4*)m)[lane + 64 * j]; s += dot4(v[j]); }
    const float r1 = 1.f / sqrtf(wave_sum(s) * (1.f / DM) + EPS);
#pragma unroll
    for (int j = 0; j < 8; ++j) { const f32x4 gv = ((const f32x4*)g1)[lane + 64 * j], hv = ((const f32x4*)hin)[lane + 64 * j]; ((f32x4*)hout)[lane + 64 * j] = hv + v[j] * r1 * gv; }
}

__device__ __forceinline__ float gelu_tanh(float x) { const float u = 0.7978845608028654f * (x + 0.044715f * x * x * x); const float t = 1.f - 2.f / (1.f + __expf(2.f * u)); return 0.5f * x * (1.f + t); }
__device__ __forceinline__ void p9_phase(const Ptrs& P, int G, int wave, int lane) {
    const int gw = blockIdx.x * NWAVES + wave, NGW = G * NWAVES;
    bf16* up = (bf16*)(P.ws + WS_UP);
    for (int it = gw; it < 1024 * 11; it += NGW) {
        const int tb = it / 11, cb = it % 11, t0 = tb * 8, ch = cb * 512 + lane * 8;
        float w0[8], w1[8], w2[8], bb[8];
#pragma unroll
        for (int q = 0; q < 2; ++q) { const f32x4 a = *(const f32x4*)(P.ffn_conv_w + ch + 4 * q), b = *(const f32x4*)(P.ffn_conv_w + DFF + ch + 4 * q), c = *(const f32x4*)(P.ffn_conv_w + 2 * DFF + ch + 4 * q), d = *(const f32x4*)(P.ffn_conv_b + ch + 4 * q);
#pragma unroll
            for (int e = 0; e < 4; ++e) { w0[4 * q + e] = a[e]; w1[4 * q + e] = b[e]; w2[4 * q + e] = c[e]; bb[4 * q + e] = d[e]; } }
        v4u prev, cur, nxt;
        prev = (t0 > 0) ? *(const v4u*)(up + (size_t)(t0 - 1) * (2 * DFF) + ch) : (v4u){0u, 0u, 0u, 0u};
        cur = *(const v4u*)(up + (size_t)t0 * (2 * DFF) + ch);
#pragma unroll
        for (int i = 0; i < 8; ++i) { const int t = t0 + i;
            nxt = (t + 1 < L) ? *(const v4u*)(up + (size_t)(t + 1) * (2 * DFF) + ch) : (v4u){0u, 0u, 0u, 0u};
            const v4u vv = *(const v4u*)(up + (size_t)t * (2 * DFF) + DFF + ch);
            const unsigned pw[4] = {prev.x, prev.y, prev.z, prev.w}, cw[4] = {cur.x, cur.y, cur.z, cur.w}, nw[4] = {nxt.x, nxt.y, nxt.z, nxt.w}, vw[4] = {vv.x, vv.y, vv.z, vv.w}; unsigned ow[4];
#pragma unroll
            for (int q = 0; q < 4; ++q) {
                const float g0 = bb[2 * q] + w0[2 * q] * bflo(pw[q]) + w1[2 * q] * bflo(cw[q]) + w2[2 * q] * bflo(nw[q]);
                const float g1 = bb[2 * q + 1] + w0[2 * q + 1] * bfhi(pw[q]) + w1[2 * q + 1] * bfhi(cw[q]) + w2[2 * q + 1] * bfhi(nw[q]);
                ow[q] = pk2(gelu_tanh(g0) * bflo(vw[q]), gelu_tanh(g1) * bfhi(vw[q])); }
            *(v4u*)(up + (size_t)t * (2 * DFF) + DFF + ch) = (v4u){ow[0], ow[1], ow[2], ow[3]};
            prev = cur; cur = nxt; }
    }
}

struct Args { Ptrs P; int ph_lo, ph_hi, coop, pad; };
__global__ void __launch_bounds__(NWAVES * 64, 2) fwd_kernel(Args args) {
    extern __shared__ __attribute__((aligned(16))) unsigned char lds_raw[];
    LAS unsigned char* lds = (LAS unsigned char*)lds_raw;
    const Ptrs& P = args.P;
    const int tid = threadIdx.x, lane = tid & 63, wave = __builtin_amdgcn_readfirstlane(tid >> 6), G = gridDim.x;
    const int gw = blockIdx.x * NWAVES + wave, NGW = G * NWAVES;
    const int lo = args.ph_lo, hi = args.ph_hi;
#define IN(k) (lo <= (k) && (k) < hi)
#define SEAM(k) do { if (IN(k) && IN((k) + 1)) { cg::this_grid().sync(); } } while (0)
    unsigned char* ws = P.ws;
    bf16* hn = (bf16*)(ws + WS_HN);

    if (IN(0)) { p0_prologue(P, lds, G, wave, lane); } SEAM(0);
    if (IN(1)) {
        pg8::Gemm g{hn, (const bf16*)(ws + WS_WIN), DM, DM, DM, 0}; pg8::StaticOrder S; S.init(L, NPROJ_PAD, G, (int)blockIdx.x);
        pg8::EpiProj E{(bf16*)(ws + WS_PROJ), (float*)(ws + WS_DTRAW)};
        pg8::gemm_phase<pg8::EpiProj, pg8::StaticOrder, true, true>(lds, g, S, E);
    } SEAM(1);
    if (IN(2)) { p2_phase(P, G, wave, lane); } SEAM(2);
    if (IN(3)) { p3_phase(P, G, wave, lane); } SEAM(3);
    if (IN(4)) { p4_phase(P, G); } SEAM(4);
    if (IN(5)) {
        for (int u = blockIdx.x; u < NCH * 2; u += G) p5_ssd_unit(P, lds, u >> 1, u & 1, tid, wave, lane);
        __syncthreads();
        {
            pg8::Gemm g{(const bf16*)(ws + WS_MIXED), (const bf16*)(ws + WS_WPOOL), 1024, 256, 256, 256}; pg8::StaticOrder S; S.init(L, 1024, G, (int)((blockIdx.x + G / 2) % G));
            pg8::EpiBf16 E{(bf16*)(ws + WS_YCAT) + 1024, DM};
            pg8::gemm_phase<pg8::EpiBf16, pg8::StaticOrder, true, true>(lds, g, S, E);
        }
        {
            pg8::Gemm g{(const bf16*)(ws + WS_PBF), (const bf16*)(ws + WS_WPLE), DPLE, DPLE, DPLE, 0}; pg8::StaticOrder S; S.init(L, DM, G, (int)blockIdx.x);
            pg8::EpiBf16 E{(bf16*)(ws + WS_PP), DM};
            pg8::gemm_phase<pg8::EpiBf16, pg8::StaticOrder, true, true>(lds, g, S, E);
        }
    } SEAM(5);
    if (IN(6)) {
        pg8::Gemm g{(const bf16*)(ws + WS_YCAT), (const bf16*)(ws + WS_WOUT), DM, DM, DM, 0}; pg8::StaticOrder S; S.init(L, DM, G, (int)blockIdx.x);
        pg8::EpiF32 E{(float*)(ws + WS_MIX), DM};
        pg8::gemm_phase<pg8::EpiF32, pg8::StaticOrder, true, true>(lds, g, S, E);
    } SEAM(6);
    if (IN(7)) {
        for (int m = gw; m < L; m += NGW) res_norm_norm_row((const float*)(ws + WS_MIX) + (size_t)m * DM, P.x + (size_t)m * DM, P.out + (size_t)m * DM, P.mix_norm_post, P.ffn_norm_pre, hn + (size_t)m * DM, lane);
    } SEAM(7);
    if (IN(8)) {
        pg8::Gemm g{hn, (const bf16*)(ws + WS_WUP), DM, DM, DM, 0}; pg8::StaticOrder S; S.init(L, 2 * DFF, G, (int)blockIdx.x);
        pg8::EpiBf16 E{(bf16*)(ws + WS_UP), 2 * DFF};
        pg8::gemm_phase<pg8::EpiBf16, pg8::StaticOrder, true, true>(lds, g, S, E);
    } SEAM(8);
    if (IN(9)) { p9_phase(P, G, wave, lane); } SEAM(9);
    if (IN(10)) {
        pg8::Gemm g{(const bf16*)(ws + WS_UP) + DFF, (const bf16*)(ws + WS_WDOWN), 2 * DFF, DFF, DFF, 0}; pg8::StaticOrder S; S.init(L, DM, G, (int)blockIdx.x);
        pg8::EpiF32 E{(float*)(ws + WS_FF), DM};
        pg8::gemm_phase<pg8::EpiF32, pg8::StaticOrder, true, true>(lds, g, S, E);
    } SEAM(10);
    if (IN(11)) {
        bf16* hn3 = (bf16*)(ws + WS_HN3);
        for (int m = gw; m < L; m += NGW) res_norm_norm_row((const float*)(ws + WS_FF) + (size_t)m * DM, P.out + (size_t)m * DM, P.out + (size_t)m * DM, P.ffn_norm_post, P.ple_norm_pre, hn3 + (size_t)m * DM, lane);
    } SEAM(11);
    if (IN(12)) {
        pg8::Gemm g{(const bf16*)(ws + WS_HN3), (const bf16*)(ws + WS_WGATE), DM, DM, DM, 0}; pg8::StaticOrder S; S.init(L, DM, G, (int)blockIdx.x);
        pg8::EpiGate E{(float*)(ws + WS_T), (const bf16*)(ws + WS_PP), DM};
        pg8::gemm_phase<pg8::EpiGate, pg8::StaticOrder, true, true>(lds, g, S, E);
    } SEAM(12);
    if (IN(13)) {
        for (int m = gw; m < L; m += NGW) res_norm_row((const float*)(ws + WS_T) + (size_t)m * DM, P.out + (size_t)m * DM, P.out + (size_t)m * DM, P.ple_norm_post, lane);
    }
#undef IN
#undef SEAM
}

extern "C" void kernel_launch(void* const* d_in, const int* in_sizes, int n_in, void* d_out, int out_size, void* d_ws, size_t ws_size, hipStream_t stream) {
    static int grid = 0;
    if (grid == 0) {
        if (n_in != 24 || in_sizes[0] != L * DM || out_size != L * DM || ws_size < WS_END) { fprintf(stderr, "kernel_launch: unexpected shapes / workspace (n_in %d, ws %zu, need %zu)\n", n_in, ws_size, (size_t)WS_END); grid = -1; return; }
        int dev = 0, cus = 0, per_cu = 0;
        hipGetDevice(&dev); hipDeviceGetAttribute(&cus, hipDeviceAttributeMultiprocessorCount, dev);
        if (hipFuncSetAttribute((const void*)fwd_kernel, hipFuncAttributeMaxDynamicSharedMemorySize, LDS_BYTES) != hipSuccess) { fprintf(stderr, "kernel_launch: hipFuncSetAttribute failed\n"); grid = -1; return; }
        if (hipOccupancyMaxActiveBlocksPerMultiprocessor(&per_cu, (const void*)fwd_kernel, NWAVES * 64, LDS_BYTES) != hipSuccess || per_cu < 1) { fprintf(stderr, "kernel_launch: occupancy query says %d\n", per_cu); per_cu = 1; }
        (void)hipGetLastError();
        grid = cus * 1;
    }
    if (grid < 0) return;
    Args a{};
    const float** pp = (const float**)&a.P;
    for (int i = 0; i < 24; ++i) pp[i] = (const float*)d_in[i];
    a.P.out = (float*)d_out; a.P.ws = (unsigned char*)d_ws;
#if MK_N_LAUNCHES == 1
    a.ph_lo = 0; a.ph_hi = N_PHASES; a.coop = 1;
    void* kargs[] = {&a};
    hipError_t e = hipLaunchCooperativeKernel((const void*)fwd_kernel, dim3(grid), dim3(NWAVES * 64), kargs, LDS_BYTES, stream);
    if (e != hipSuccess) fprintf(stderr, "cooperative launch failed: %s (grid %d)\n", hipGetErrorString(e), grid);
#else
    for (int li = 0; li < N_PHASES; ++li) { a.ph_lo = li; a.ph_hi = li + 1; a.coop = 0;
        hipLaunchKernelGGL(fwd_kernel, dim3(grid), dim3(NWAVES * 64), LDS_BYTES, stream, a); }
#endif
}
```

```cpp
#include <hip/hip_runtime.h>
#include <hip/hip_cooperative_groups.h>
#include <cstdio>
#include <cstdint>
namespace cg = cooperative_groups;

namespace pg8 {
#define PG8_LAS __attribute__((address_space(3)))
typedef unsigned short bf16_t;
typedef short bf16x8 __attribute__((ext_vector_type(8)));
typedef float f32x4 __attribute__((ext_vector_type(4)));
typedef unsigned u32x4 __attribute__((ext_vector_type(4)));
typedef unsigned u32x2 __attribute__((ext_vector_type(2)));
constexpr int BM = 256, BK = 64, HALF = 128, HTB = HALF * BK * 2  , STAGE_BYTES = 8 * HTB, NXCD = 8, WGM = 8;

__host__ __device__ __forceinline__ int lds_byte(int r, int c) { const int st = (r >> 4) * 2 + (c >> 5), rr = r & 15, cc = c & 31, ob = rr * 64 + cc * 2; return st * 1024 + (ob ^ (((ob >> 9) & 1) << 5)); }
__host__ __device__ __forceinline__ void stage_rc(int b, int& R, int& C) { const int st = b / 1024, sb = b % 1024, swz = sb ^ (((sb >> 9) & 1) << 5); R = (st >> 1) * 16 + swz / 64; C = (st & 1) * 32 + (swz % 64) / 2; }
__host__ __device__ __forceinline__ int perm32(int rho) { const int n = rho >> 4, i = rho & 15; return 8 * (i >> 2) + 4 * n + (i & 3); }

struct Unit { int pm, pn; };
struct Gemm { const bf16_t* A; const bf16_t* Bt; int lda, ldb, K, a_pn_off;
    __device__ __forceinline__ const char* a_ptr(const Unit& u) const { return (const char*)(A + (size_t)u.pm * BM * lda + (size_t)u.pn * a_pn_off); }
    __device__ __forceinline__ const char* b_ptr(const Unit& u) const { return (const char*)(Bt + (size_t)u.pn * BM * ldb); }
};

struct StaticOrder {
    int nM, nN, nwg, G, c;
    __host__ __device__ void init(int M, int N, int G_, int c_) { nM = M / BM; nN = N / BM; nwg = nM * nN; G = G_; c = c_; }
    __host__ __device__ bool next(int i, Unit& u) const {
        const long L = (long)i * G + c; if (L >= nwg) return false;
        int wgid = (int)L; { const int q = nwg / NXCD, r = nwg % NXCD, xcd = wgid % NXCD, off = wgid / NXCD; wgid = (xcd < r ? xcd * (q + 1) : r * (q + 1) + (xcd - r) * q) + off; }
        const int nig = WGM * nN, gid = wgid / nig, fm = gid * WGM, gsz = (nM - fm) < WGM ? (nM - fm) : WGM;
        u.pm = fm + ((wgid % nig) % gsz); u.pn = (wgid % nig) / gsz; return true;
    }
    __device__ __forceinline__ void a_ready(const Unit&) const {}
    __device__ __forceinline__ void done(const Unit&) const {}
};

__device__ __forceinline__ unsigned cvt_pk_bf16(float lo, float hi) { unsigned r; asm volatile("v_cvt_pk_bf16_f32 %0, %1, %2" : "=v"(r) : "v"(lo), "v"(hi)); return r; }

struct EpiBf16 {
    static constexpr bool PERM = true, AFTER_DRAIN = false;
    bf16_t* O; int ldc;
    __device__ __forceinline__ void operator()(const f32x4 (&acc)[2][2][4][2], const Unit& u, int wr, int wc, int fr, int fq) const {
        const int row0 = u.pm * BM + wr * 64 + fr; const int col0 = u.pn * BM + wc * 32 + 8 * fq;
#pragma unroll
        for (int ai = 0; ai < 2; ++ai)
#pragma unroll
            for (int m = 0; m < 4; ++m) { bf16_t* rowp = O + (size_t)(row0 + ai * HALF + m * 16) * ldc + col0;
#pragma unroll
                for (int bj = 0; bj < 2; ++bj) { const f32x4 v0 = acc[ai][bj][m][0], v1 = acc[ai][bj][m][1];
                    u32x4 w; w.x = cvt_pk_bf16(v0[0], v0[1]); w.y = cvt_pk_bf16(v0[2], v0[3]); w.z = cvt_pk_bf16(v1[0], v1[1]); w.w = cvt_pk_bf16(v1[2], v1[3]);
                    *(u32x4*)(rowp + bj * HALF) = w; } }
    }
};
struct EpiProj {
    static constexpr bool PERM = true, AFTER_DRAIN = false;
    bf16_t* O; float* dtraw;
    __device__ __forceinline__ void operator()(const f32x4 (&acc)[2][2][4][2], const Unit& u, int wr, int wc, int fr, int fq) const {
        const int row0 = u.pm * BM + wr * 64 + fr;
        if (u.pn < 14) { const int col0 = u.pn * BM + wc * 32 + 8 * fq;
#pragma unroll
            for (int ai = 0; ai < 2; ++ai)
#pragma unroll
                for (int m = 0; m < 4; ++m) { bf16_t* rowp = O + (size_t)(row0 + ai * HALF + m * 16) * 3584 + col0;
#pragma unroll
                    for (int bj = 0; bj < 2; ++bj) { const f32x4 v0 = acc[ai][bj][m][0], v1 = acc[ai][bj][m][1];
                        u32x4 w; w.x = cvt_pk_bf16(v0[0], v0[1]); w.y = cvt_pk_bf16(v0[2], v0[3]); w.z = cvt_pk_bf16(v1[0], v1[1]); w.w = cvt_pk_bf16(v1[2], v1[3]);
                        *(u32x4*)(rowp + bj * HALF) = w; } }
        } else if (wc == 0) {
#pragma unroll
            for (int ai = 0; ai < 2; ++ai)
#pragma unroll
                for (int m = 0; m < 4; ++m) { float* rp = dtraw + (size_t)(row0 + ai * HALF + m * 16) * 32 + 8 * fq;
                    *(f32x4*)rp = acc[ai][0][m][0]; *(f32x4*)(rp + 4) = acc[ai][0][m][1]; }
        }
    }
};

__device__ __forceinline__ float dpp_ror1(float x) { return __builtin_bit_cast(float, __builtin_amdgcn_update_dpp(0, __builtin_bit_cast(int, x), 0x121, 0xf, 0xf, false)); }
__device__ __forceinline__ float dpp_ror15(float x) { return __builtin_bit_cast(float, __builtin_amdgcn_update_dpp(0, __builtin_bit_cast(int, x), 0x12f, 0xf, 0xf, false)); }
__device__ __forceinline__ float gelu_tanh_f(float x) { const float u = 0.7978845608028654f * (x + 0.044715f * x * x * x); const float t = 1.f - 2.f / (1.f + __expf(2.f * u)); return 0.5f * x * (1.f + t); }
struct EpiGlu {
    static constexpr bool PERM = true, AFTER_DRAIN = false;
    bf16_t* act; float* E; const float* cw; const float* cbias; PG8_LAS unsigned char* xl;
    __device__ __forceinline__ void operator()(const f32x4 (&acc)[2][2][4][2], const Unit& u, int wr, int wc, int fr, int fq) const {
        const int cl = wc * 32 + 8 * fq, ch = u.pn * 128 + cl;
        PG8_LAS float* X = (PG8_LAS float*)xl;
#pragma unroll
        for (int ai = 0; ai < 2; ++ai) { const int rb = ai * 2 + wr;
#pragma unroll
            for (int n = 0; n < 2; ++n) { const f32x4 top = acc[ai][0][0][n], bot = acc[ai][0][3][n]; f32x4 sel;
                sel[0] = fr == 0 ? top[0] : bot[0]; sel[1] = fr == 0 ? top[1] : bot[1]; sel[2] = fr == 0 ? top[2] : bot[2]; sel[3] = fr == 0 ? top[3] : bot[3];
                if (fr == 0 || fr == 15) *(PG8_LAS f32x4*)(X + (rb * 2 + (fr == 15 ? 1 : 0)) * 128 + cl + 4 * n) = sel; } }
        float* Ep = E + (size_t)u.pm * 6 * 5632 + ch;
#pragma unroll
        for (int n = 0; n < 2; ++n) { const f32x4 g0 = acc[0][0][0][n], g1 = acc[1][0][3][n], v0 = acc[0][1][0][n], v1 = acc[1][1][3][n]; f32x4 gs, vs;
#pragma unroll
            for (int j = 0; j < 4; ++j) { gs[j] = wr ? g1[j] : g0[j]; vs[j] = wr ? v1[j] : v0[j]; }
            const bool gc = wr ? (fr >= 14) : (fr < 2); const int gi = wr ? fr - 12 : fr;
            if (gc) *(f32x4*)(Ep + (size_t)gi * 5632 + 4 * n) = gs;
            if (wr ? (fr == 15) : (fr == 0)) *(f32x4*)(Ep + (size_t)(4 + wr) * 5632 + 4 * n) = vs; }
        asm volatile("s_waitcnt lgkmcnt(0)" ::: "memory"); __builtin_amdgcn_s_barrier(); asm volatile("" ::: "memory");
#pragma unroll
        for (int n = 0; n < 2; ++n) {
            const f32x4 w0 = *(const f32x4*)(cw + ch + 4 * n), w1 = *(const f32x4*)(cw + 5632 + ch + 4 * n), w2 = *(const f32x4*)(cw + 2 * 5632 + ch + 4 * n), bb = *(const f32x4*)(cbias + ch + 4 * n);
#pragma unroll
            for (int ai = 0; ai < 2; ++ai) { const int rb = ai * 2 + wr;
                const f32x4 xp = rb > 0 ? *(const PG8_LAS f32x4*)(X + ((rb - 1) * 2 + 1) * 128 + cl + 4 * n) : (f32x4){0.f, 0.f, 0.f, 0.f};
                const f32x4 xn = rb < 3 ? *(const PG8_LAS f32x4*)(X + ((rb + 1) * 2 + 0) * 128 + cl + 4 * n) : (f32x4){0.f, 0.f, 0.f, 0.f};
#pragma unroll
                for (int m = 0; m < 4; ++m) { float o[4]; const f32x4 g = acc[ai][0][m][n], v = acc[ai][1][m][n];
#pragma unroll
                    for (int j = 0; j < 4; ++j) {
                        const float up1 = dpp_ror1(g[j]), dn1 = dpp_ror15(g[j]);
                        const float pmv = (m > 0) ? dpp_ror1(acc[ai][0][m > 0 ? m - 1 : 0][n][j]) : xp[j];
                        const float nmv = (m < 3) ? dpp_ror15(acc[ai][0][m < 3 ? m + 1 : 3][n][j]) : xn[j];
                        const float prev = fr ? up1 : pmv, next = (fr < 15) ? dn1 : nmv;
                        const float a = bb[j] + w0[j] * prev + w1[j] * g[j] + w2[j] * next;
                        o[j] = gelu_tanh_f(a) * v[j]; }
                    u32x2 w; w.x = cvt_pk_bf16(o[0], o[1]); w.y = cvt_pk_bf16(o[2], o[3]);
                    *(u32x2*)(act + (size_t)(u.pm * BM + ai * HALF + wr * 64 + m * 16 + fr) * 5632 + ch + 4 * n) = w; }
                asm volatile("" ::: "memory"); } }
    }
};
struct EpiF32 {
    static constexpr bool PERM = false, AFTER_DRAIN = false;
    float* out; int ldc;
    __device__ __forceinline__ void operator()(const f32x4 (&acc)[2][2][4][2], const Unit& u, int wr, int wc, int fr, int fq) const {
        const int col0 = u.pn * BM + wc * 32 + 4 * fq;
#pragma unroll
        for (int ai = 0; ai < 2; ++ai)
#pragma unroll
            for (int m = 0; m < 4; ++m) { const size_t off = (size_t)(u.pm * BM + ai * HALF + wr * 64 + m * 16 + fr) * ldc + col0;
#pragma unroll
                for (int bj = 0; bj < 2; ++bj)
#pragma unroll
                    for (int n = 0; n < 2; ++n) *(f32x4*)(out + off + bj * HALF + n * 16) = acc[ai][bj][m][n]; }
    }
};
struct EpiGate {
    static constexpr bool PERM = false, AFTER_DRAIN = false;
    float* out; const bf16_t* pp; int ldc;
    __device__ __forceinline__ void operator()(const f32x4 (&acc)[2][2][4][2], const Unit& u, int wr, int wc, int fr, int fq) const {
        const int col0 = u.pn * BM + wc * 32 + 4 * fq;
#pragma unroll
        for (int ai = 0; ai < 2; ++ai)
#pragma unroll
            for (int m = 0; m < 4; ++m) { const size_t off = (size_t)(u.pm * BM + ai * HALF + wr * 64 + m * 16 + fr) * ldc + col0;
#pragma unroll
                for (int bj = 0; bj < 2; ++bj)
#pragma unroll
                    for (int n = 0; n < 2; ++n) { const u32x2 pv = *(const u32x2*)(pp + off + bj * HALF + n * 16); const f32x4 a = acc[ai][bj][m][n]; f32x4 o;
                        o[0] = __uint_as_float(pv.x << 16) / (1.f + __expf(-a[0])); o[1] = __uint_as_float(pv.x & 0xffff0000u) / (1.f + __expf(-a[1]));
                        o[2] = __uint_as_float(pv.y << 16) / (1.f + __expf(-a[2])); o[3] = __uint_as_float(pv.y & 0xffff0000u) / (1.f + __expf(-a[3]));
                        *(f32x4*)(out + off + bj * HALF + n * 16) = o; } }
    }
};

template <class Epi, class Sched, bool ALIGN_EPI = false, bool SP2 = false>
__device__ __forceinline__ void gemm_phase(PG8_LAS unsigned char* lds, const Gemm g, const Sched& S, const Epi& E) {
    int tid_ = threadIdx.x; asm volatile("" : "+v"(tid_));
    const int tid = tid_, wid = __builtin_amdgcn_readfirstlane(tid >> 6), lane = tid & 63, wr = wid >> 2, wc = wid & 3, fr = lane & 15, fq = lane >> 4;
    const int K = g.K, nt = K / BK;
    unsigned voffA[2], voffB[2];
#pragma unroll
    for (int i = 0; i < 2; ++i) { int R, C; stage_rc(tid * 16 + i * 8192, R, C); const int Rb = Epi::PERM ? ((R & ~31) + perm32(R & 31)) : R;
        voffA[i] = (unsigned)(R * g.lda + C) * 2u; voffB[i] = (unsigned)(Rb * g.ldb + C) * 2u; }
    const size_t kstep = (size_t)(BK * 2);
    const size_t hstepA = (size_t)HALF * g.lda * 2, hstepB = (size_t)HALF * g.ldb * 2;
    const unsigned ldsw = (unsigned)wid * 1024u;
    const int aoff = lds_byte(wr * 64 + fr, fq * 8), boff = lds_byte(wc * 32 + fr, fq * 8);
#define PG8_SA(b, h) (((b) * 2 + (h)) * HTB)
#define PG8_SB(b, h) ((4 + (b) * 2 + (h)) * HTB)
#define PG8_STAGE(bufoff, gbase, voff) do { _Pragma("unroll") for (int _i = 0; _i < 2; ++_i) \
        __builtin_amdgcn_global_load_lds((const unsigned*)((const char*)(gbase) + (voff)[_i]), (PG8_LAS unsigned*)(lds + (bufoff) + ldsw + _i * 8192), 16, 0, 0); } while (0)
#define PG8_LDA(dst, b, h) do { _Pragma("unroll") for (int m = 0; m < 4; ++m) _Pragma("unroll") for (int k = 0; k < 2; ++k) dst[m][k] = *(const PG8_LAS bf16x8*)(lds + PG8_SA(b, h) + aoff + m * 2048 + k * 1024); } while (0)
#define PG8_LDB(dst, b, h) do { _Pragma("unroll") for (int n = 0; n < 2; ++n) _Pragma("unroll") for (int k = 0; k < 2; ++k) dst[n][k] = *(const PG8_LAS bf16x8*)(lds + PG8_SB(b, h) + boff + n * 2048 + k * 1024); } while (0)
#define PG8_MMA(ai, bj, At, Bt) do { __builtin_amdgcn_s_setprio(1); _Pragma("unroll") for (int m = 0; m < 4; ++m) _Pragma("unroll") for (int n = 0; n < 2; ++n) _Pragma("unroll") for (int k = 0; k < 2; ++k) \
        acc[ai][bj][m][n] = __builtin_amdgcn_mfma_f32_16x16x32_bf16(Bt[n][k], At[m][k], acc[ai][bj][m][n], 0, 0, 0); __builtin_amdgcn_s_setprio(0); } while (0)
#define PG8_WAIT_V(n) asm volatile("s_waitcnt vmcnt(" #n ")" ::: "memory")
#define PG8_WAIT_L(n) asm volatile("s_waitcnt lgkmcnt(" #n ")" ::: "memory")
#define PG8_BAR __builtin_amdgcn_s_barrier()
#define PG8_SCHED __builtin_amdgcn_sched_barrier(0)
    Unit cur, nxt; int ui = 0;
    if (!S.next(0, cur)) return;
    f32x4 acc[2][2][4][2];
#pragma unroll
    for (int a = 0; a < 2; ++a)
#pragma unroll
        for (int b = 0; b < 2; ++b)
#pragma unroll
            for (int m = 0; m < 4; ++m)
#pragma unroll
                for (int n = 0; n < 2; ++n) acc[a][b][m][n] = (f32x4){0.f, 0.f, 0.f, 0.f};
    bf16x8 At[4][2], B0[2][2], B1[2][2];
    const char* cA = g.a_ptr(cur); const char* cB = g.b_ptr(cur);
    S.a_ready(cur);
    if constexpr (SP2) {
        PG8_STAGE(PG8_SB(0, 0), cB, voffB); PG8_STAGE(PG8_SB(0, 1), cB + hstepB, voffB); PG8_STAGE(PG8_SA(0, 0), cA, voffA); PG8_STAGE(PG8_SA(0, 1), cA + hstepA, voffA);
        if (wr == 1) PG8_BAR;
        PG8_WAIT_V(2); PG8_BAR;
        PG8_STAGE(PG8_SB(1, 0), cB + kstep, voffB); PG8_STAGE(PG8_SA(1, 0), cA + kstep, voffA); PG8_STAGE(PG8_SB(1, 1), cB + hstepB + kstep, voffB);
        PG8_WAIT_V(6); PG8_BAR;
    } else {
        PG8_STAGE(PG8_SB(0, 0), cB, voffB); PG8_STAGE(PG8_SA(0, 0), cA, voffA); PG8_STAGE(PG8_SB(0, 1), cB + hstepB, voffB); PG8_STAGE(PG8_SA(0, 1), cA + hstepA, voffA);
        if (wr == 1) PG8_BAR;
        PG8_WAIT_V(4); PG8_BAR;
        PG8_STAGE(PG8_SB(1, 0), cB + kstep, voffB); PG8_STAGE(PG8_SA(1, 0), cA + kstep, voffA); PG8_STAGE(PG8_SB(1, 1), cB + hstepB + kstep, voffB);
        PG8_WAIT_V(6); PG8_BAR;
    }
    for (;;) {
        const bool has_next = S.next(ui + 1, nxt);
        const char* nA = has_next ? g.a_ptr(nxt) : cA; const char* nB = has_next ? g.b_ptr(nxt) : cB;
        for (int t = 0; t < nt; t += 2) {
            const bool last = (t == nt - 2);
            const char* a1 = cA + (size_t)(t + 1) * kstep;
            const char* a2 = last ? nA : cA + (size_t)(t + 2) * kstep; const char* b2 = last ? nB : cB + (size_t)(t + 2) * kstep;
            const char* a3 = a2 + kstep; const char* b3 = b2 + kstep;
            if (last && has_next) S.a_ready(nxt);
            if constexpr (SP2) {
            PG8_LDB(B0, 0, 0); PG8_LDB(B1, 0, 1); PG8_SCHED; PG8_LDA(At, 0, 0); PG8_STAGE(PG8_SA(1, 1), a1 + hstepA, voffA);
            PG8_WAIT_V(8); PG8_WAIT_L(0); PG8_BAR; PG8_MMA(0, 0, At, B0); PG8_MMA(0, 1, At, B1); PG8_BAR; PG8_SCHED;
            PG8_LDA(At, 0, 1); PG8_STAGE(PG8_SB(0, 0), b2, voffB); PG8_STAGE(PG8_SB(0, 1), b2 + hstepB, voffB); PG8_STAGE(PG8_SA(0, 0), a2, voffA);
            PG8_WAIT_V(8); PG8_WAIT_L(0); PG8_BAR; PG8_MMA(1, 0, At, B0); PG8_MMA(1, 1, At, B1); PG8_BAR; PG8_SCHED;
            PG8_LDB(B0, 1, 0); PG8_LDB(B1, 1, 1); PG8_SCHED; PG8_LDA(At, 1, 0); PG8_STAGE(PG8_SA(0, 1), a2 + hstepA, voffA);
            PG8_WAIT_V(8); PG8_WAIT_L(0); PG8_BAR; PG8_MMA(0, 0, At, B0); PG8_MMA(0, 1, At, B1); PG8_BAR; PG8_SCHED;
            PG8_LDA(At, 1, 1); PG8_STAGE(PG8_SB(1, 0), b3, voffB); PG8_STAGE(PG8_SB(1, 1), b3 + hstepB, voffB); PG8_STAGE(PG8_SA(1, 0), a3, voffA);
            PG8_WAIT_V(8); PG8_WAIT_L(0); PG8_BAR; PG8_MMA(1, 0, At, B0); PG8_MMA(1, 1, At, B1); PG8_BAR; PG8_SCHED;
            } else {
            PG8_LDB(B0, 0, 0); PG8_SCHED; PG8_LDA(At, 0, 0); PG8_STAGE(PG8_SA(1, 1), a1 + hstepA, voffA);
            PG8_WAIT_L(8); PG8_BAR; PG8_WAIT_L(0); PG8_MMA(0, 0, At, B0); PG8_BAR; PG8_SCHED;
            PG8_LDB(B1, 0, 1); PG8_STAGE(PG8_SB(0, 0), b2, voffB);
            PG8_BAR; PG8_WAIT_L(0); PG8_MMA(0, 1, At, B1); PG8_BAR;
            PG8_LDA(At, 0, 1); PG8_STAGE(PG8_SA(0, 0), a2, voffA);
            PG8_BAR; PG8_WAIT_L(0); PG8_MMA(1, 0, At, B0); PG8_BAR; PG8_SCHED;
            PG8_STAGE(PG8_SB(0, 1), b2 + hstepB, voffB);
            PG8_WAIT_V(6); PG8_BAR; PG8_MMA(1, 1, At, B1); PG8_BAR;
            PG8_LDB(B0, 1, 0); PG8_SCHED; PG8_LDA(At, 1, 0); PG8_STAGE(PG8_SA(0, 1), a2 + hstepA, voffA);
            PG8_WAIT_L(8); PG8_BAR; PG8_WAIT_L(0); PG8_MMA(0, 0, At, B0); PG8_BAR; PG8_SCHED;
            PG8_LDB(B1, 1, 1); PG8_STAGE(PG8_SB(1, 0), b3, voffB);
            PG8_BAR; PG8_WAIT_L(0); PG8_MMA(0, 1, At, B1); PG8_BAR;
            PG8_LDA(At, 1, 1); PG8_STAGE(PG8_SA(1, 0), a3, voffA);
            PG8_BAR; PG8_WAIT_L(0); PG8_MMA(1, 0, At, B0); PG8_BAR; PG8_SCHED;
            PG8_STAGE(PG8_SB(1, 1), b3 + hstepB, voffB);
            PG8_WAIT_V(6); PG8_BAR; PG8_MMA(1, 1, At, B1); PG8_BAR;
            }
        }
        if constexpr (ALIGN_EPI) { if (wr == 0) PG8_BAR; }
        if constexpr (!Epi::AFTER_DRAIN) { E(acc, cur, wr, wc, fr, fq); S.done(cur); }
        if (!has_next) break;
#pragma unroll
        for (int a = 0; a < 2; ++a)
#pragma unroll
            for (int b = 0; b < 2; ++b)
#pragma unroll
                for (int m = 0; m < 4; ++m)
#pragma unroll
                    for (int n = 0; n < 2; ++n) acc[a][b][m][n] = (f32x4){0.f, 0.f, 0.f, 0.f};
        cur = nxt; cA = nA; cB = nB; ++ui;
        if constexpr (ALIGN_EPI) { if (wr == 1) PG8_BAR; }
    }
    PG8_WAIT_V(0);
    if constexpr (!ALIGN_EPI) { if (wr == 0) PG8_BAR; }
    PG8_BAR;
    if constexpr (Epi::AFTER_DRAIN) { E.fused(acc, cur, wr, wc, fr, fq, lds, wid, lane); S.done(cur); }
#undef PG8_SA
#undef PG8_SB
#undef PG8_STAGE
#undef PG8_LDA
#undef PG8_LDB
#undef PG8_MMA
#undef PG8_WAIT_V
#undef PG8_WAIT_L
#undef PG8_BAR
#undef PG8_SCHED
}
}

constexpr int NWAVES = 8;
constexpr int L = 8192, DM = 2048, DSSD = 1024, NH = 16, NCH = 64  , DFF = 5632, DPLE = 256;
constexpr int NPROJ = 3584;
constexpr int NPROJ_PAD = 3840;
constexpr float EPS = 1e-6f;
#ifndef MK_N_LAUNCHES
#define MK_N_LAUNCHES 1
#endif
constexpr int N_PHASES = 14;
#ifndef DUP_MASK
#define DUP_MASK 0u
#endif

constexpr size_t MiB = 1u << 20;
constexpr size_t WS_WDOWN = 1 * MiB, WS_WUP = 23 * MiB, WS_HN = 67 * MiB, WS_PP = 99 * MiB, WS_WGATE = 131 * MiB, WS_WPLE = 139 * MiB, WS_WPOOL = 140 * MiB;
constexpr size_t WS_UP = 141 * MiB;
constexpr size_t WS_WIN = 141 * MiB, WS_WOUT = 156 * MiB, WS_PROJ = 164 * MiB, WS_YCAT = 224 * MiB, WS_MIXED = 256 * MiB, WS_XST = 272 * MiB;
constexpr size_t WS_BM = 288 * MiB, WS_BMT = 292 * MiB, WS_CM = 296 * MiB, WS_TAB = 300 * MiB, WS_DTRAW = 302 * MiB, WS_HIN = 304 * MiB, WS_PBF = 336 * MiB;
constexpr size_t WS_STATES = 67 * MiB;
constexpr size_t WS_MIX = 256 * MiB;
constexpr size_t WS_FF = 23 * MiB;
constexpr size_t WS_ACT = 141 * MiB;
constexpr size_t WS_EDGE = 229 * MiB;
constexpr size_t WS_HN3 = 234 * MiB, WS_T = 266 * MiB;
constexpr size_t WS_END = 340 * MiB;

constexpr int LDS_BYTES = 155648;
constexpr int LDS_XCH = 131072, LDS_MISC = 155648 - 256;
constexpr int CW_BAR = 4096;
constexpr size_t CTL_ZERO_BYTES = 65536;

#define LAS __attribute__((address_space(3)))
typedef unsigned short bf16;
typedef unsigned v4u __attribute__((ext_vector_type(4)));
typedef unsigned v2u __attribute__((ext_vector_type(2)));
typedef float f32x4 __attribute__((ext_vector_type(4)));
typedef float f32x2 __attribute__((ext_vector_type(2)));
typedef short bf16x8 __attribute__((ext_vector_type(8)));
#define LDS_WAIT() asm volatile("s_waitcnt lgkmcnt(0)" ::: "memory")
__device__ __forceinline__ unsigned f2bf(float f) { unsigned u = __builtin_bit_cast(unsigned, f); return (u + 0x7fffu + ((u >> 16) & 1u)) >> 16; }
__device__ __forceinline__ unsigned pk2(float lo, float hi) { return f2bf(lo) | (f2bf(hi) << 16); }
__device__ __forceinline__ float bf2f(bf16 b) { return __uint_as_float((unsigned)b << 16); }
__device__ __forceinline__ float bflo(unsigned u) { return __uint_as_float(u << 16); }
__device__ __forceinline__ float bfhi(unsigned u) { return __uint_as_float(u & 0xffff0000u); }
__device__ __forceinline__ float wave_sum(float v) {
#pragma unroll
    for (int o = 1; o < 64; o <<= 1) v += __shfl_xor(v, o);
    return v;
}
__device__ __forceinline__ float dot4(f32x4 a) { return (a.x * a.x + a.y * a.y) + (a.z * a.z + a.w * a.w); }

#define XB_TMO      128
#define XB_XCNT(j)  (256  + 64 * (j))
#define XB_XSUB(j)  (1280 + 64 * (j))
#define XB_XGEN(j)  (2304 + 64 * (j))
#define XB_TOP      3328
#define XB_TOPGEN   3392
#define XCD_BAR_WORDS 3456
#define XB_SPIN_CAP (1u << 18)

__device__ __forceinline__ unsigned xb_ld(unsigned* p)              { return __hip_atomic_load(p, __ATOMIC_RELAXED, __HIP_MEMORY_SCOPE_AGENT); }
__device__ __forceinline__ unsigned xb_add(unsigned* p, unsigned v) { return __hip_atomic_fetch_add(p, v, __ATOMIC_RELAXED, __HIP_MEMORY_SCOPE_AGENT); }
__device__ __forceinline__ unsigned xb_xcc_id() { return (unsigned)__builtin_amdgcn_s_getreg((3 << 11) | 20) & 0xFu; }
#define XB_SPIN(cond, bar) do { unsigned _sp = 0; while (cond) { __builtin_amdgcn_s_sleep(1); \
    if ((++_sp & 255u) == 0u) { if (xb_ld(&(bar)[XB_TMO])) break; if (_sp > XB_SPIN_CAP) { atomicAdd(&(bar)[XB_TMO], 1u); break; } } } } while (0)

struct XcdBarrier {
    unsigned* bar; unsigned x;
    volatile LAS unsigned* st;
};

__device__ __forceinline__ XcdBarrier xcd_barrier_post(unsigned* bar, volatile LAS unsigned* st) {
    XcdBarrier b; b.bar = bar; b.x = xb_xcc_id(); b.st = st;
    if (threadIdx.x == 0) (void)xb_add(&bar[XB_XCNT(b.x)], 1u);
    return b;
}
__device__ __forceinline__ void xcd_barrier_complete(unsigned* bar, unsigned x, unsigned& nloc, unsigned& nx) {
    const unsigned G = gridDim.x * gridDim.y * gridDim.z;
    unsigned sum, cnt, mine, sp = 0u;
    for (;;) {
        sum = 0u; cnt = 0u; mine = 0u;
#pragma unroll
        for (unsigned j = 0; j < 16; ++j) { const unsigned c = xb_ld(&bar[XB_XCNT(j)]); sum += c; cnt += (c > 0u) ? 1u : 0u; mine = (j == x) ? c : mine; }
        if (sum == G) break;
        __builtin_amdgcn_s_sleep(1);
        if ((++sp & 255u) == 0u) { if (xb_ld(&bar[XB_TMO])) break; if (sp > XB_SPIN_CAP) { atomicAdd(&bar[XB_TMO], 1u); break; } }
    }
    nloc = mine > 0u ? mine : 1u; nx = cnt > 0u ? cnt : 1u;
}

__device__ __forceinline__ void xcd_barrier(const XcdBarrier& b) {
    asm volatile("s_waitcnt vmcnt(0)" ::: "memory");
    __syncthreads();
    if (threadIdx.x == 0) {
        unsigned* bar = b.bar;
        __builtin_amdgcn_s_waitcnt(0);
        unsigned nloc = b.st[0], nx = b.st[1];
        if (nloc == 0u) { xcd_barrier_complete(bar, b.x, nloc, nx); b.st[0] = nloc; b.st[1] = nx; }
        const unsigned old = xb_add(&bar[XB_XSUB(b.x)], 1u);
        const unsigned gen = old / nloc;
        if (old + 1u == (gen + 1u) * nloc) {
            __builtin_amdgcn_fence(__ATOMIC_RELEASE, "agent");
            asm volatile("s_waitcnt vmcnt(0)" ::: "memory");
            const unsigned og = xb_add(&bar[XB_TOP], 1u);
            const unsigned tg = og / nx;
            if (og + 1u == (tg + 1u) * nx) xb_add(&bar[XB_TOPGEN], 1u);
            else XB_SPIN(xb_ld(&bar[XB_TOPGEN]) == tg, bar);
            __builtin_amdgcn_fence(__ATOMIC_ACQUIRE, "agent");
            xb_add(&bar[XB_XGEN(b.x)], 1u);
            asm volatile("s_waitcnt vmcnt(0)" ::: "memory");
        } else {
            XB_SPIN(xb_ld(&bar[XB_XGEN(b.x)]) == gen, bar);
            __builtin_amdgcn_fence(__ATOMIC_ACQUIRE, "agent");
            asm volatile("s_waitcnt vmcnt(0)" ::: "memory");
        }
    }
    __syncthreads();
}

struct Ptrs {
    const float *x, *p, *mix_norm_pre, *mix_norm_post, *w_in, *ssd_conv_w, *ssd_conv_b, *ssd_dt_bias, *ssd_a_log, *ssd_d, *ssd_norm, *pool_w, *pool_scale, *w_out,
        *ffn_norm_pre, *ffn_norm_post, *w_ffn_up, *ffn_conv_w, *ffn_conv_b, *w_ffn_down, *ple_norm_pre, *w_ple_gate, *w_ple, *ple_norm_post;
    float* out; unsigned char* ws;
};

__device__ __forceinline__ void p0_transpose_item(const float* W, int N, bf16* WT, int ldt, int drow0, int k0, int n0, const float* scale, LAS float* scr, int lane) {
#pragma unroll 8
    for (int i = 0; i < 32; ++i) { const int kk = 2 * i + (lane >> 5); scr[kk * 33 + (lane & 31)] = W[(size_t)(k0 + kk) * N + n0 + (lane & 31)]; }
    LDS_WAIT(); asm volatile("" ::: "memory");
    const int c = lane & 7;
#pragma unroll
    for (int j = 0; j < 4; ++j) { const int n = (lane >> 3) + 8 * j; const LAS float* s = scr + (8 * c) * 33 + n; const float sc = scale ? scale[n0 + n] : 1.f;
        v4u o; o.x = pk2(s[0 * 33] * sc, s[1 * 33] * sc); o.y = pk2(s[2 * 33] * sc, s[3 * 33] * sc); o.z = pk2(s[4 * 33] * sc, s[5 * 33] * sc); o.w = pk2(s[6 * 33] * sc, s[7 * 33] * sc);
        *(v4u*)(WT + (size_t)(drow0 + n) * ldt + k0 + 8 * c) = o; }
    LDS_WAIT(); asm volatile("" ::: "memory");
}
__device__ __forceinline__ void rms_row_to_bf16(const float* xrow, const float* g, bf16* orow, int lane) {
    const f32x4* xr = (const f32x4*)xrow + lane; f32x4 v[8]; float s = 0.f;
#pragma unroll
    for (int j = 0; j < 8; ++j) { v[j] = xr[64 * j]; s += dot4(v[j]); }
    const float r = 1.f / sqrtf(wave_sum(s) * (1.f / DM) + EPS);
#pragma unroll
    for (int j = 0; j < 8; ++j) { const f32x4 gv = ((const f32x4*)g)[lane + 64 * j]; const f32x4 o = v[j] * r * gv;
        *(v2u*)(orow + (size_t)(lane + 64 * j) * 4) = (v2u){pk2(o.x, o.y), pk2(o.z, o.w)}; }
}
__device__ __forceinline__ void p0_prologue(const Ptrs& P, LAS unsigned char* lds, int G, int wave, int lane) {
    LAS float* scr = (LAS float*)(lds + wave * 16384);
    const int gw = blockIdx.x * NWAVES + wave, NGW = G * NWAVES;
    bf16* w_inT = (bf16*)(P.ws + WS_WIN); bf16* w_outT = (bf16*)(P.ws + WS_WOUT); bf16* w_upT = (bf16*)(P.ws + WS_WUP); bf16* w_downT = (bf16*)(P.ws + WS_WDOWN);
    bf16* w_gateT = (bf16*)(P.ws + WS_WGATE); bf16* w_pleT = (bf16*)(P.ws + WS_WPLE); bf16* w_poolT = (bf16*)(P.ws + WS_WPOOL);
    constexpr int I_IN = 32 * 113, I_OUT = 32 * 64, I_UP = 32 * 352, I_DOWN = 88 * 64, I_GATE = 32 * 64, I_PLE = 4 * 64, I_POOL = 4 * 32;
    constexpr int NITEMS = I_IN + I_OUT + I_UP + I_DOWN + I_GATE + I_PLE + I_POOL;
    for (int it = gw; it < NITEMS; it += NGW) {
        int r = it;
        if (r < I_IN) { const int kb = r / 113, nb = r % 113; const int drow = nb < 80 ? nb * 32 : (nb == 80 ? 3584 : (nb - 1) * 32);
            p0_transpose_item(P.w_in, 3616, w_inT, DM, drow, kb * 64, nb * 32, nullptr, scr, lane); continue; } r -= I_IN;
        if (r < I_OUT) { const int kb = r / 64, nb = r % 64; p0_transpose_item(P.w_out, DM, w_outT, DM, nb * 32, kb * 64, nb * 32, nullptr, scr, lane); continue; } r -= I_OUT;
        if (r < I_UP) { const int kb = r / 352, nb = r % 352; const int isv = nb >= 176, c0 = (nb - isv * 176) * 32; const int drow = (c0 >> 7) * 256 + isv * 128 + (c0 & 127);
            p0_transpose_item(P.w_ffn_up, 2 * DFF, w_upT, DM, drow, kb * 64, nb * 32, nullptr, scr, lane); continue; } r -= I_UP;
        if (r < I_DOWN) { const int kb = r / 64, nb = r % 64; p0_transpose_item(P.w_ffn_down, DM, w_downT, DFF, nb * 32, kb * 64, nb * 32, nullptr, scr, lane); continue; } r -= I_DOWN;
        if (r < I_GATE) { const int kb = r / 64, nb = r % 64; p0_transpose_item(P.w_ple_gate, DM, w_gateT, DM, nb * 32, kb * 64, nb * 32, nullptr, scr, lane); continue; } r -= I_GATE;
        if (r < I_PLE) { const int kb = r / 64, nb = r % 64; p0_transpose_item(P.w_ple, DM, w_pleT, DPLE, nb * 32, kb * 64, nb * 32, nullptr, scr, lane); continue; } r -= I_PLE;
        { const int gi = r / 32, q = r % 32, kb = q / 8, nb = q % 8;
          p0_transpose_item(P.pool_w + (size_t)gi * 65536, 256, w_poolT + (size_t)gi * 65536, 256, nb * 32, kb * 64, nb * 32, P.pool_scale + gi * 256, scr, lane); }
    }
    { v4u* zp = (v4u*)(w_inT + (size_t)3616 * DM); const int nz = 224 * DM * 2 / 16;
      for (int i = gw * 64 + lane; i < nz; i += NGW * 64) zp[i] = (v4u){0u, 0u, 0u, 0u}; }
    { const f32x4* ps = (const f32x4*)P.p; v2u* pd = (v2u*)(P.ws + WS_PBF); const int np = L * DPLE / 4;
      for (int i = gw * 64 + lane; i < np; i += NGW * 64) { const f32x4 v = ps[i]; pd[i] = (v2u){pk2(v.x, v.y), pk2(v.z, v.w)}; } }
    bf16* hn = (bf16*)(P.ws + WS_HN);
    for (int m = gw; m < L; m += NGW) rms_row_to_bf16(P.x + (size_t)m * DM, P.mix_norm_pre, hn + (size_t)m * DM, lane);
}

__device__ __forceinline__ float softplus_f(float x) { return fmaxf(x, 0.f) + log1pf(__expf(-fabsf(x))); }
template <int K> __device__ __forceinline__ void pool_item(const bf16* src, bf16* dst, int t0) {
    constexpr int H = K / 2, NR = 8 + K - 1;
    float v[NR];
#pragma unroll
    for (int r = 0; r < NR; ++r) { const int t = t0 - H + r; v[r] = (t >= 0 && t < L) ? bf2f(src[(size_t)t * NPROJ]) : 0.f; }
#pragma unroll
    for (int i = 0; i < 8; ++i) { const int t = t0 + i; const int lo = t - H > 0 ? t - H : 0, hi = t + H < L ? t + H : L; float s = 0.f;
#pragma unroll
        for (int r = 0; r < K; ++r) s += v[i + r];
        const float o = s / (float)(hi - lo) - v[i + H]; dst[(size_t)t * 1024] = (bf16)f2bf(o); }
}
__device__ __forceinline__ void p2_phase(const Ptrs& P, int G, int wave, int lane) {
    const int gw = blockIdx.x * NWAVES + wave, NGW = G * NWAVES;
    const bf16* proj = (const bf16*)(P.ws + WS_PROJ); const float* dtraw = (const float*)(P.ws + WS_DTRAW); float* tab = (float*)(P.ws + WS_TAB);
    bf16* xsT = (bf16*)(P.ws + WS_XST); bf16* Bm = (bf16*)(P.ws + WS_BM); bf16* BmT = (bf16*)(P.ws + WS_BMT); bf16* Cm = (bf16*)(P.ws + WS_CM); bf16* mixed = (bf16*)(P.ws + WS_MIXED);
    for (int id = gw; id < NCH * 2 * NH; id += NGW) {
        const int c = id >> 5, dir = (id >> 4) & 1, h = id & 15;
        const float bias = P.ssd_dt_bias[dir * NH + h], a = -__expf(P.ssd_a_log[dir * NH + h]);
        const int i0 = 2 * lane, i1 = 2 * lane + 1, l0 = dir ? 127 - i0 : i0, l1 = dir ? 127 - i1 : i1;
        const float dt0 = softplus_f(dtraw[(size_t)(c * 128 + l0) * 32 + dir * NH + h] + bias), dt1 = softplus_f(dtraw[(size_t)(c * 128 + l1) * 32 + dir * NH + h] + bias);
        const float da0 = dt0 * a, da1 = dt1 * a; float s = da0 + da1;
#pragma unroll
        for (int o = 1; o < 64; o <<= 1) { const float t = __shfl_up(s, o); if (lane >= o) s += t; }
        const float excl = s - (da0 + da1);
        float* ta = tab + ((size_t)(dir * NCH + c) * NH + h) * 128; float* td = tab + ((size_t)((2 + dir) * NCH + c) * NH + h) * 128;
        ta[l0] = excl + da0; ta[l1] = s; td[l0] = dt0; td[l1] = dt1;
    }
    for (int it = gw; it < 1024 * 24; it += NGW) {
        const int tb = it / 24, cb = it % 24, t0 = tb * 8, ch = cb * 64 + lane;
        const bf16* src = proj + 1024 + ch; float v[12];
#pragma unroll
        for (int r = 0; r < 12; ++r) { const int t = t0 - 2 + r; v[r] = (t >= 0 && t < L) ? bf2f(src[(size_t)t * NPROJ]) : 0.f; }
        float w[5];
#pragma unroll
        for (int j = 0; j < 5; ++j) w[j] = P.ssd_conv_w[j * 1536 + ch];
        const float b = P.ssd_conv_b[ch]; float o[8];
#pragma unroll
        for (int i = 0; i < 8; ++i) { float a = b;
#pragma unroll
            for (int j = 0; j < 5; ++j) a += w[j] * v[i + j];
            o[i] = a / (1.f + __expf(-a)); }
        const v4u pk = (v4u){pk2(o[0], o[1]), pk2(o[2], o[3]), pk2(o[4], o[5]), pk2(o[6], o[7])};
        const int c = t0 >> 7, l0 = t0 & 127;
        if (cb < 16) {
            *(v4u*)(xsT + ((size_t)((c * NH + cb) * 64 + lane)) * 128 + l0) = pk;
        } else if (cb < 20) {
            const int gn = ch - 1024, g = gn >> 7, n = gn & 127;
            *(v4u*)(BmT + ((size_t)((c * 2 + g) * 128 + n)) * 128 + l0) = pk;
#pragma unroll
            for (int i = 0; i < 8; ++i) Bm[(size_t)(t0 + i) * 256 + gn] = (bf16)f2bf(o[i]);
        } else {
            const int cn = ch - 1280;
#pragma unroll
            for (int i = 0; i < 8; ++i) Cm[(size_t)(t0 + i) * 256 + cn] = (bf16)f2bf(o[i]);
        }
    }
    for (int it = gw; it < 1024 * 16; it += NGW) {
        const int tb = it >> 4, cb = it & 15, t0 = tb * 8, ch = cb * 64 + lane, gi = cb >> 2;
        const bf16* src = proj + 2560 + ch; bf16* dst = mixed + ch;
        if (gi == 0) pool_item<2>(src, dst, t0); else if (gi == 1) pool_item<4>(src, dst, t0); else if (gi == 2) pool_item<8>(src, dst, t0); else pool_item<16>(src, dst, t0);
    }
}

__device__ __forceinline__ void p3_phase(const Ptrs& P, int G, int wave, int lane) {
    const int gw = blockIdx.x * NWAVES + wave, NGW = G * NWAVES, fr = lane & 15, fq = lane >> 4;
    const float* tab = (const float*)(P.ws + WS_TAB); const bf16* xsT = (const bf16*)(P.ws + WS_XST); const bf16* BmT = (const bf16*)(P.ws + WS_BMT); float* states = (float*)(P.ws + WS_STATES);
    for (int id = gw; id < NCH * 2 * NH; id += NGW) {
        const int c = id >> 5, dir = (id >> 4) & 1, h = id & 15, g = h >> 3;
        const float* ta = tab + ((size_t)(dir * NCH + c) * NH + h) * 128; const float* td = tab + ((size_t)((2 + dir) * NCH + c) * NH + h) * 128;
        const float a_end = dir ? ta[0] : ta[127];
        f32x4 acc[4][8];
#pragma unroll
        for (int mt = 0; mt < 4; ++mt)
#pragma unroll
            for (int nt = 0; nt < 8; ++nt) acc[mt][nt] = (f32x4){0.f, 0.f, 0.f, 0.f};
#pragma unroll 1
        for (int kk = 0; kk < 4; ++kk) {
            const int lb = kk * 32 + fq * 8;
            const f32x4 a0 = *(const f32x4*)(ta + lb), a1 = *(const f32x4*)(ta + lb + 4), d0 = *(const f32x4*)(td + lb), d1 = *(const f32x4*)(td + lb + 4);
            float w[8];
#pragma unroll
            for (int i = 0; i < 4; ++i) { w[i] = d0[i] * __expf(a_end - a0[i]); w[4 + i] = d1[i] * __expf(a_end - a1[i]); }
            bf16x8 Af[4];
#pragma unroll
            for (int mt = 0; mt < 4; ++mt) { const v4u raw = *(const v4u*)(xsT + ((size_t)((c * NH + h) * 64 + mt * 16 + fr)) * 128 + lb);
                v4u sc; sc.x = pk2(bflo(raw.x) * w[0], bfhi(raw.x) * w[1]); sc.y = pk2(bflo(raw.y) * w[2], bfhi(raw.y) * w[3]);
                sc.z = pk2(bflo(raw.z) * w[4], bfhi(raw.z) * w[5]); sc.w = pk2(bflo(raw.w) * w[6], bfhi(raw.w) * w[7]);
                Af[mt] = __builtin_bit_cast(bf16x8, sc); }
#pragma unroll
            for (int nt = 0; nt < 8; ++nt) { const bf16x8 Bf = *(const bf16x8*)(BmT + ((size_t)((c * 2 + g) * 128 + nt * 16 + fr)) * 128 + lb);
#pragma unroll
                for (int mt = 0; mt < 4; ++mt) acc[mt][nt] = __builtin_amdgcn_mfma_f32_16x16x32_bf16(Bf, Af[mt], acc[mt][nt], 0, 0, 0); }
        }
        float* so = states + ((size_t)((dir * NCH + c) * NH + h)) * 64 * 128;
#pragma unroll
        for (int mt = 0; mt < 4; ++mt)
#pragma unroll
            for (int nt = 0; nt < 8; ++nt) *(f32x4*)(so + (size_t)(mt * 16 + fr) * 128 + nt * 16 + fq * 4) = acc[mt][nt];
    }
}

__device__ __forceinline__ void p4_phase(const Ptrs& P, int G) {
    const float* tab = (const float*)(P.ws + WS_TAB); const float* states = (const float*)(P.ws + WS_STATES); bf16* hin = (bf16*)(P.ws + WS_HIN);
    for (int e = blockIdx.x * 512 + threadIdx.x; e < 2 * NH * 64 * 64; e += G * 512) {
        const int n2 = e & 63, p = (e >> 6) & 63, h = (e >> 12) & 15, dir = e >> 16;
        const size_t eo = (size_t)p * 128 + 2 * n2, cstride = (size_t)NH * 64 * 128;
        const float* sb = states + ((size_t)(dir * NCH) * NH + h) * 64 * 128 + eo; bf16* hb = hin + ((size_t)(dir * NCH) * NH + h) * 64 * 128 + eo;
        const float* ta = tab + ((size_t)(dir * NCH) * NH + h) * 128 + (dir ? 0 : 127);
        f32x2 st = (f32x2){0.f, 0.f};
#pragma unroll 1
        for (int i0 = 0; i0 < NCH; i0 += 8) {
            f32x2 sv[8]; float cd[8];
#pragma unroll
            for (int j = 0; j < 8; ++j) { const int c = dir ? NCH - 1 - (i0 + j) : i0 + j; sv[j] = *(const f32x2*)(sb + (size_t)c * cstride); cd[j] = ta[(size_t)c * NH * 128]; }
#pragma unroll
            for (int j = 0; j < 8; ++j) { const int c = dir ? NCH - 1 - (i0 + j) : i0 + j;
                *(unsigned*)(hb + (size_t)c * cstride) = pk2(st.x, st.y);
                const float d = __expf(cd[j]); st = st * d + sv[j]; }
        }
    }
}

__device__ __forceinline__ void p5_ssd_unit(const Ptrs& P, LAS unsigned char* lds, int c, int g, int tid, int wave, int lane) {
    const int fr = lane & 15, fq = lane >> 4;
    const float* tab = (const float*)(P.ws + WS_TAB); const bf16* xsT = (const bf16*)(P.ws + WS_XST); const bf16* Bm = (const bf16*)(P.ws + WS_BM); const bf16* Cm = (const bf16*)(P.ws + WS_CM);
    const bf16* hin = (const bf16*)(P.ws + WS_HIN); const bf16* proj = (const bf16*)(P.ws + WS_PROJ); bf16* ycat = (bf16*)(P.ws + WS_YCAT);
    LAS float* T = (LAS float*)lds;
    LAS v2u* ybuf = (LAS v2u*)(lds + 16384 + wave * 16384);
    __syncthreads();
    for (int idx = tid; idx < 4 * 8 * 128; idx += 512) { const int which = idx >> 10, hh = (idx >> 7) & 7, l = idx & 127; T[idx] = tab[((size_t)(which * NCH + c) * NH + g * 8 + hh) * 128 + l]; }
    __syncthreads();
    const int t0 = c * 128, lrow = wave * 16 + fr;
    bf16x8 Cf[4];
#pragma unroll
    for (int kk = 0; kk < 4; ++kk) Cf[kk] = *(const bf16x8*)(Cm + (size_t)(t0 + lrow) * 256 + g * 128 + kk * 32 + fq * 8);
    f32x4 cb[8];
#pragma unroll
    for (int st = 0; st < 8; ++st) { cb[st] = (f32x4){0.f, 0.f, 0.f, 0.f};
#pragma unroll
        for (int kk = 0; kk < 4; ++kk) { const bf16x8 Bf = *(const bf16x8*)(Bm + (size_t)(t0 + st * 16 + fr) * 256 + g * 128 + kk * 32 + fq * 8);
            cb[st] = __builtin_amdgcn_mfma_f32_16x16x32_bf16(Bf, Cf[kk], cb[st], 0, 0, 0); } }
    float sumsq = 0.f;
#pragma unroll 1
    for (int hh = 0; hh < 8; ++hh) {
        const int h = g * 8 + hh;
        const float alf = T[(0 * 8 + hh) * 128 + lrow], alb = T[(1 * 8 + hh) * 128 + lrow], dsk = P.ssd_d[h];
        bf16x8 Mf[4];
#pragma unroll
        for (int kk = 0; kk < 4; ++kk) { float mv[8];
#pragma unroll
            for (int hf = 0; hf < 2; ++hf) { const int st = 2 * kk + hf, s0 = st * 16 + fq * 4;
                const f32x4 asf = *(const LAS f32x4*)(T + (0 * 8 + hh) * 128 + s0), asb = *(const LAS f32x4*)(T + (1 * 8 + hh) * 128 + s0);
                const f32x4 dsf = *(const LAS f32x4*)(T + (2 * 8 + hh) * 128 + s0), dsb = *(const LAS f32x4*)(T + (3 * 8 + hh) * 128 + s0);
#pragma unroll
                for (int r = 0; r < 4; ++r) { const int s = s0 + r;
                    const float vf = (s <= lrow) ? __expf(fminf(alf - asf[r], 0.f)) * dsf[r] : 0.f;
                    const float vb = (s >= lrow) ? __expf(fminf(alb - asb[r], 0.f)) * dsb[r] : 0.f;
                    mv[hf * 4 + r] = cb[st][r] * (vf + vb) + ((s == lrow) ? dsk : 0.f); } }
            const v4u pk = (v4u){pk2(mv[0], mv[1]), pk2(mv[2], mv[3]), pk2(mv[4], mv[5]), pk2(mv[6], mv[7])};
            Mf[kk] = __builtin_bit_cast(bf16x8, pk); }
        f32x4 accY[4], accF[4], accB[4];
#pragma unroll
        for (int pt = 0; pt < 4; ++pt) { accY[pt] = (f32x4){0.f, 0.f, 0.f, 0.f}; accF[pt] = accY[pt]; accB[pt] = accY[pt]; }
        const bf16* xh = xsT + ((size_t)(c * NH + h) * 64) * 128;
        const bf16* hf_ = hin + ((size_t)((0 * NCH + c) * NH + h) * 64) * 128; const bf16* hb_ = hin + ((size_t)((1 * NCH + c) * NH + h) * 64) * 128;
#pragma unroll
        for (int kk = 0; kk < 4; ++kk)
#pragma unroll
            for (int pt = 0; pt < 4; ++pt) { const bf16* xr = xh + (size_t)(pt * 16 + fr) * 128;
                const v2u lo = *(const v2u*)(xr + (2 * kk) * 16 + fq * 4), hi = *(const v2u*)(xr + (2 * kk + 1) * 16 + fq * 4);
                const bf16x8 Xf = __builtin_bit_cast(bf16x8, ((v4u){lo.x, lo.y, hi.x, hi.y}));
                accY[pt] = __builtin_amdgcn_mfma_f32_16x16x32_bf16(Xf, Mf[kk], accY[pt], 0, 0, 0);
                const bf16x8 Hf = *(const bf16x8*)(hf_ + (size_t)(pt * 16 + fr) * 128 + kk * 32 + fq * 8);
                accF[pt] = __builtin_amdgcn_mfma_f32_16x16x32_bf16(Hf, Cf[kk], accF[pt], 0, 0, 0);
                const bf16x8 Hb = *(const bf16x8*)(hb_ + (size_t)(pt * 16 + fr) * 128 + kk * 32 + fq * 8);
                accB[pt] = __builtin_amdgcn_mfma_f32_16x16x32_bf16(Hb, Cf[kk], accB[pt], 0, 0, 0); }
        const float ef = __expf(alf), eb = __expf(alb);
#pragma unroll
        for (int pt = 0; pt < 4; ++pt) {
            const v2u zr = *(const v2u*)(proj + (size_t)(t0 + lrow) * NPROJ + h * 64 + pt * 16 + fq * 4);
            const float z[4] = {bflo(zr.x), bfhi(zr.x), bflo(zr.y), bfhi(zr.y)}; float y[4];
#pragma unroll
            for (int r = 0; r < 4; ++r) { y[r] = (accY[pt][r] + ef * accF[pt][r] + eb * accB[pt][r]) * (z[r] / (1.f + __expf(-z[r]))); sumsq += y[r] * y[r]; }
            ybuf[(hh * 4 + pt) * 64 + lane] = (v2u){pk2(y[0], y[1]), pk2(y[2], y[3])}; }
    }
    sumsq += __shfl_xor(sumsq, 16); sumsq += __shfl_xor(sumsq, 32);
    const float rs = 1.f / sqrtf(sumsq * (1.f / 512.f) + EPS);
    LDS_WAIT();
#pragma unroll
    for (int hh = 0; hh < 8; ++hh)
#pragma unroll
        for (int pt = 0; pt < 4; ++pt) { const v2u yv = ybuf[(hh * 4 + pt) * 64 + lane]; const int ch = g * 512 + hh * 64 + pt * 16 + fq * 4; const f32x4 nw = *(const f32x4*)(P.ssd_norm + ch);
            *(v2u*)(ycat + (size_t)(t0 + lrow) * DM + ch) = (v2u){pk2(bflo(yv.x) * rs * nw.x, bfhi(yv.x) * rs * nw.y), pk2(bflo(yv.y) * rs * nw.z, bfhi(yv.y) * rs * nw.w)}; }
}

__device__ __forceinline__ void res_norm_norm_row(const float* m, const float* hin, float* hout, const float* g1, const float* g2, bf16* hn, int lane) {
    f32x4 v[8]; float s = 0.f;
#pragma unroll
    for (int j = 0; j < 8; ++j) { v[j] = ((const f32x4*)m)[lane + 64 * j]; s += dot4(v[j]); }
    const float r1 = 1.f / sqrtf(wave_sum(s) * (1.f / DM) + EPS); float s2 = 0.f;
#pragma unroll
    for (int j = 0; j < 8; ++j) { const f32x4 gv = ((const f32x4*)g1)[lane + 64 * j], hv = ((const f32x4*)hin)[lane + 64 * j]; v[j] = hv + v[j] * r1 * gv; s2 += dot4(v[j]); ((f32x4*)hout)[lane + 64 * j] = v[j]; }
    const float r2 = 1.f / sqrtf(wave_sum(s2) * (1.f / DM) + EPS);
#pragma unroll
    for (int j = 0; j < 8; ++j) { const f32x4 gv = ((const f32x4*)g2)[lane + 64 * j]; const f32x4 o = v[j] * r2 * gv; *(v2u*)(hn + (size_t)(lane + 64 * j) * 4) = (v2u){pk2(o.x, o.y), pk2(o.z, o.w)}; }
}
__device__ __forceinline__ void res_norm_row(const float* m, const float* hin, float* hout, const float* g1, int lane) {
    f32x4 v[8]; float s = 0.f;
#pragma unroll
    for (int j = 0; j < 8; ++j) { v[j] = ((const f32x4*)m)[lane + 64 * j]; s += dot4(v[j]); }
    const float r1 = 1.f / sqrtf(wave_sum(s) * (1.f / DM) + EPS);
#pragma unroll
    for (int j = 0; j < 8; ++j) { const f32x4 gv = ((const f32x4*)g1)[lane + 64 * j], hv = ((const f32x4*)hin)[lane + 64 * j]; ((f32x4*)hout)[lane + 64 * j] = hv + v[j] * r1 * gv; }
}

__device__ __forceinline__ float gelu_tanh(float x) { const float u = 0.7978845608028654f * (x + 0.044715f * x * x * x); const float t = 1.f - 2.f / (1.f + __expf(2.f * u)); return 0.5f * x * (1.f + t); }
__device__ __forceinline__ void p9_phase(const Ptrs& P, int G, int wave, int lane) {
    const int gw = blockIdx.x * NWAVES + wave, NGW = G * NWAVES;
    bf16* up = (bf16*)(P.ws + WS_UP);
    for (int it = gw; it < 1024 * 11; it += NGW) {
        const int tb = it / 11, cb = it % 11, t0 = tb * 8, ch = cb * 512 + lane * 8;
        float w0[8], w1[8], w2[8], bb[8];
#pragma unroll
        for (int q = 0; q < 2; ++q) { const f32x4 a = *(const f32x4*)(P.ffn_conv_w + ch + 4 * q), b = *(const f32x4*)(P.ffn_conv_w + DFF + ch + 4 * q), c = *(const f32x4*)(P.ffn_conv_w + 2 * DFF + ch + 4 * q), d = *(const f32x4*)(P.ffn_conv_b + ch + 4 * q);
#pragma unroll
            for (int e = 0; e < 4; ++e) { w0[4 * q + e] = a[e]; w1[4 * q + e] = b[e]; w2[4 * q + e] = c[e]; bb[4 * q + e] = d[e]; } }
        v4u prev, cur, nxt;
        prev = (t0 > 0) ? *(const v4u*)(up + (size_t)(t0 - 1) * (2 * DFF) + ch) : (v4u){0u, 0u, 0u, 0u};
        cur = *(const v4u*)(up + (size_t)t0 * (2 * DFF) + ch);
#pragma unroll
        for (int i = 0; i < 8; ++i) { const int t = t0 + i;
            nxt = (t + 1 < L) ? *(const v4u*)(up + (size_t)(t + 1) * (2 * DFF) + ch) : (v4u){0u, 0u, 0u, 0u};
            const v4u vv = *(const v4u*)(up + (size_t)t * (2 * DFF) + DFF + ch);
            const unsigned pw[4] = {prev.x, prev.y, prev.z, prev.w}, cw[4] = {cur.x, cur.y, cur.z, cur.w}, nw[4] = {nxt.x, nxt.y, nxt.z, nxt.w}, vw[4] = {vv.x, vv.y, vv.z, vv.w}; unsigned ow[4];
#pragma unroll
            for (int q = 0; q < 4; ++q) {
                const float g0 = bb[2 * q] + w0[2 * q] * bflo(pw[q]) + w1[2 * q] * bflo(cw[q]) + w2[2 * q] * bflo(nw[q]);
                const float g1 = bb[2 * q + 1] + w0[2 * q + 1] * bfhi(pw[q]) + w1[2 * q + 1] * bfhi(cw[q]) + w2[2 * q + 1] * bfhi(nw[q]);
                ow[q] = pk2(gelu_tanh(g0) * bflo(vw[q]), gelu_tanh(g1) * bfhi(vw[q])); }
            *(v4u*)(up + (size_t)t * (2 * DFF) + DFF + ch) = (v4u){ow[0], ow[1], ow[2], ow[3]};
            prev = cur; cur = nxt; }
    }
}

struct Args { Ptrs P; int ph_lo, ph_hi, coop, pad; };
__global__ void __launch_bounds__(NWAVES * 64, 2) fwd_kernel(Args args) {
    extern __shared__ __attribute__((aligned(16))) unsigned char lds_raw[];
    LAS unsigned char* lds = (LAS unsigned char*)lds_raw;
    const Ptrs& P = args.P;
    const int G = gridDim.x;
#define PH_VARS int tid_ = threadIdx.x; asm volatile("" : "+v"(tid_)); const int tid = tid_, lane = tid & 63, wave = __builtin_amdgcn_readfirstlane(tid >> 6), gw = blockIdx.x * NWAVES + wave, NGW = G * NWAVES; (void)tid; (void)lane; (void)gw; (void)NGW;
    const int lo = args.ph_lo, hi = args.ph_hi;
#define IN(k) (lo <= (k) && (k) < hi)
    volatile LAS unsigned* MISC = (volatile LAS unsigned*)(lds + LDS_MISC);
    if (threadIdx.x < 32) MISC[threadIdx.x] = 0u;
    __syncthreads();
    XcdBarrier bar; bar.bar = (unsigned*)P.ws + CW_BAR; bar.x = 0; bar.st = nullptr;
    if (args.coop) bar = xcd_barrier_post((unsigned*)P.ws + CW_BAR, MISC + 8);
    if (args.coop == 2) cg::this_grid().sync();
#define SEAM(k) do { if (IN(k) && IN((k) + 1)) { xcd_barrier(bar); } } while (0)
    unsigned char* ws = P.ws;
#define HN ((bf16*)(ws + WS_HN))

    if (IN(0)) { PH_VARS p0_prologue(P, lds, G, wave, lane); } SEAM(0);
    if (IN(1)) {
        pg8::Gemm g{HN, (const bf16*)(ws + WS_WIN), DM, DM, DM, 0}; pg8::StaticOrder S; S.init(L, NPROJ_PAD, G, (int)blockIdx.x);
        pg8::EpiProj E{(bf16*)(ws + WS_PROJ), (float*)(ws + WS_DTRAW)};
        pg8::gemm_phase<pg8::EpiProj, pg8::StaticOrder, true, true>(lds, g, S, E);
    } SEAM(1);
    if (IN(2)) { PH_VARS p2_phase(P, G, wave, lane); } SEAM(2);
    if (IN(3)) { PH_VARS p3_phase(P, G, wave, lane); } SEAM(3);
    if (IN(4)) { p4_phase(P, G); } SEAM(4);
    if (IN(5)) { PH_VARS
        for (int u = blockIdx.x; u < NCH * 2; u += G) p5_ssd_unit(P, lds, u >> 1, u & 1, tid, wave, lane);
        __syncthreads();
        int k256 = 256; asm volatile("" : "+s"(k256));
        {
            pg8::Gemm g{(const bf16*)(ws + WS_MIXED), (const bf16*)(ws + WS_WPOOL), 1024, 256, k256, 256}; pg8::StaticOrder S; S.init(L, 1024, G, (int)((blockIdx.x + G / 2) % G));
            pg8::EpiBf16 E{(bf16*)(ws + WS_YCAT) + 1024, DM};
            pg8::gemm_phase<pg8::EpiBf16, pg8::StaticOrder, true, true>(lds, g, S, E);
        }
        {
            pg8::Gemm g{(const bf16*)(ws + WS_PBF), (const bf16*)(ws + WS_WPLE), DPLE, DPLE, k256, 0}; pg8::StaticOrder S; S.init(L, DM, G, (int)blockIdx.x);
            pg8::EpiBf16 E{(bf16*)(ws + WS_PP), DM};
            pg8::gemm_phase<pg8::EpiBf16, pg8::StaticOrder, true, true>(lds, g, S, E);
        }
    } SEAM(5);
    if (IN(6)) {
        pg8::Gemm g{(const bf16*)(ws + WS_YCAT), (const bf16*)(ws + WS_WOUT), DM, DM, DM, 0}; pg8::StaticOrder S; S.init(L, DM, G, (int)blockIdx.x);
        pg8::EpiF32 E{(float*)(ws + WS_MIX), DM};
        pg8::gemm_phase<pg8::EpiF32, pg8::StaticOrder, true, true>(lds, g, S, E);
    } SEAM(6);
    if (IN(7)) { PH_VARS
        for (int m = gw; m < L; m += NGW) res_norm_norm_row((const float*)(ws + WS_MIX) + (size_t)m * DM, P.x + (size_t)m * DM, P.out + (size_t)m * DM, P.mix_norm_post, P.ffn_norm_pre, HN + (size_t)m * DM, lane);
    } SEAM(7);
    if (IN(8)) {
        pg8::Gemm g{HN, (const bf16*)(ws + WS_WUP), DM, DM, DM, 0}; pg8::StaticOrder S; S.init(L, 2 * DFF, G, (int)blockIdx.x);
        pg8::EpiGlu E{(bf16*)(ws + WS_ACT), (float*)(ws + WS_EDGE), P.ffn_conv_w, P.ffn_conv_b, lds + LDS_XCH};
        pg8::gemm_phase<pg8::EpiGlu, pg8::StaticOrder, true, true>(lds, g, S, E);
    } SEAM(8);
    if (IN(10)) { PH_VARS
        pg8::Gemm g{(const bf16*)(ws + WS_ACT), (const bf16*)(ws + WS_WDOWN), DFF, DFF, DFF, 0}; pg8::StaticOrder S; S.init(L, DM, G, (int)blockIdx.x);
        { pg8::Unit u0; if (S.next(0, u0)) { const int pm = u0.pm; const float* E = (const float*)(ws + WS_EDGE); bf16* act = (bf16*)(ws + WS_ACT); const float* Ec = E + (size_t)pm * 6 * DFF;
            for (int idx = tid; idx < 2 * DFF; idx += NWAVES * 64) { const int which = idx >= DFF, ch = idx - which * DFF; float prev, cur, next, val; int row;
                if (!which) { prev = pm > 0 ? E[((size_t)(pm - 1) * 6 + 3) * DFF + ch] : 0.f; cur = Ec[0 * DFF + ch]; next = Ec[1 * DFF + ch]; val = Ec[4 * DFF + ch]; row = 256 * pm; }
                else { prev = Ec[2 * DFF + ch]; cur = Ec[3 * DFF + ch]; next = pm < 31 ? E[((size_t)(pm + 1) * 6 + 0) * DFF + ch] : 0.f; val = Ec[5 * DFF + ch]; row = 256 * pm + 255; }
                const float a = P.ffn_conv_b[ch] + P.ffn_conv_w[ch] * prev + P.ffn_conv_w[DFF + ch] * cur + P.ffn_conv_w[2 * DFF + ch] * next;
                act[(size_t)row * DFF + ch] = (bf16)f2bf(pg8::gelu_tanh_f(a) * val); } }
          __builtin_amdgcn_fence(__ATOMIC_SEQ_CST, "agent"); __syncthreads(); }
        pg8::EpiF32 E{(float*)(ws + WS_FF), DM};
        pg8::gemm_phase<pg8::EpiF32, pg8::StaticOrder, true, true>(lds, g, S, E);
    } SEAM(10);
    if (IN(11)) { PH_VARS
        bf16* hn3 = (bf16*)(ws + WS_HN3);
        for (int m = gw; m < L; m += NGW) res_norm_norm_row((const float*)(ws + WS_FF) + (size_t)m * DM, P.out + (size_t)m * DM, P.out + (size_t)m * DM, P.ffn_norm_post, P.ple_norm_pre, hn3 + (size_t)m * DM, lane);
    } SEAM(11);
    if (IN(12)) {
        pg8::Gemm g{(const bf16*)(ws + WS_HN3), (const bf16*)(ws + WS_WGATE), DM, DM, DM, 0}; pg8::StaticOrder S; S.init(L, DM, G, (int)blockIdx.x);
        pg8::EpiGate E{(float*)(ws + WS_T), (const bf16*)(ws + WS_PP), DM};
        pg8::gemm_phase<pg8::EpiGate, pg8::StaticOrder, true, true>(lds, g, S, E);
    } SEAM(12);
    if (IN(13)) { PH_VARS
        for (int m = gw; m < L; m += NGW) res_norm_row((const float*)(ws + WS_T) + (size_t)m * DM, P.out + (size_t)m * DM, P.out + (size_t)m * DM, P.ple_norm_post, lane);
    }
#undef IN
#undef SEAM
}

extern "C" void kernel_launch(void* const* d_in, const int* in_sizes, int n_in, void* d_out, int out_size, void* d_ws, size_t ws_size, hipStream_t stream) {
    static int grid = 0;
    if (grid == 0) {
        if (n_in != 24 || in_sizes[0] != L * DM || out_size != L * DM || ws_size < WS_END) { fprintf(stderr, "kernel_launch: unexpected shapes / workspace (n_in %d, ws %zu, need %zu)\n", n_in, ws_size, (size_t)WS_END); grid = -1; return; }
        int dev = 0, cus = 0, per_cu = 0;
        hipGetDevice(&dev); hipDeviceGetAttribute(&cus, hipDeviceAttributeMultiprocessorCount, dev);
        if (hipFuncSetAttribute((const void*)fwd_kernel, hipFuncAttributeMaxDynamicSharedMemorySize, LDS_BYTES) != hipSuccess) { fprintf(stderr, "kernel_launch: hipFuncSetAttribute failed\n"); grid = -1; return; }
        if (hipOccupancyMaxActiveBlocksPerMultiprocessor(&per_cu, (const void*)fwd_kernel, NWAVES * 64, LDS_BYTES) != hipSuccess || per_cu < 1) { fprintf(stderr, "kernel_launch: occupancy query says %d\n", per_cu); per_cu = 1; }
        (void)hipGetLastError();
        grid = cus * 1;
    }
    if (grid < 0) return;
    Args a{};
    const float** pp = (const float**)&a.P;
    for (int i = 0; i < 24; ++i) pp[i] = (const float*)d_in[i];
    a.P.out = (float*)d_out; a.P.ws = (unsigned char*)d_ws;
#if MK_N_LAUNCHES == 1
    if (hipMemsetAsync(d_ws, 0, CTL_ZERO_BYTES, stream) != hipSuccess) { fprintf(stderr, "kernel_launch: memset of the barrier words failed\n"); return; }
    a.ph_lo = 0; a.ph_hi = N_PHASES; a.coop = 1;
    void* kargs[] = {&a};
    hipError_t e = hipLaunchCooperativeKernel((const void*)fwd_kernel, dim3(grid), dim3(NWAVES * 64), kargs, LDS_BYTES, stream);
    if (e != hipSuccess) fprintf(stderr, "cooperative launch failed: %s (grid %d)\n", hipGetErrorString(e), grid);
#else
    for (int li = 0; li < N_PHASES; ++li) { a.ph_lo = li; a.ph_hi = li + 1; a.coop = 0;
        for (int rep = 0; rep < 1 + (int)((DUP_MASK >> li) & 1u); ++rep) hipLaunchKernelGGL(fwd_kernel, dim3(grid), dim3(NWAVES * 64), LDS_BYTES, stream, a); }
#endif
}
```

```cpp
#include <hip/hip_runtime.h>
#include <hip/hip_cooperative_groups.h>
#include <cstdio>
#include <cstdint>
namespace cg = cooperative_groups;

namespace pg8 {
#define PG8_LAS __attribute__((address_space(3)))
typedef unsigned short bf16_t;
typedef short bf16x8 __attribute__((ext_vector_type(8)));
typedef float f32x4 __attribute__((ext_vector_type(4)));
typedef unsigned u32x4 __attribute__((ext_vector_type(4)));
typedef unsigned u32x2 __attribute__((ext_vector_type(2)));
constexpr int BM = 256, BK = 64, HALF = 128, HTB = HALF * BK * 2  , STAGE_BYTES = 8 * HTB, NXCD = 8, WGM = 8;

__host__ __device__ __forceinline__ int lds_byte(int r, int c) { const int st = (r >> 4) * 2 + (c >> 5), rr = r & 15, cc = c & 31, ob = rr * 64 + cc * 2; return st * 1024 + (ob ^ (((ob >> 9) & 1) << 5)); }
__host__ __device__ __forceinline__ void stage_rc(int b, int& R, int& C) { const int st = b / 1024, sb = b % 1024, swz = sb ^ (((sb >> 9) & 1) << 5); R = (st >> 1) * 16 + swz / 64; C = (st & 1) * 32 + (swz % 64) / 2; }
__host__ __device__ __forceinline__ int perm32(int rho) { const int n = rho >> 4, i = rho & 15; return 8 * (i >> 2) + 4 * n + (i & 3); }

struct Unit { int pm, pn; };
struct Gemm { const bf16_t* A; const bf16_t* Bt; int lda, ldb, K, a_pn_off;
    __device__ __forceinline__ const char* a_ptr(const Unit& u) const { return (const char*)(A + (size_t)u.pm * BM * lda + (size_t)u.pn * a_pn_off); }
    __device__ __forceinline__ const char* b_ptr(const Unit& u) const { return (const char*)(Bt + (size_t)u.pn * BM * ldb); }
};

struct StaticOrder {
    int nM, nN, nwg, G, c;
    __host__ __device__ void init(int M, int N, int G_, int c_) { nM = M / BM; nN = N / BM; nwg = nM * nN; G = G_; c = c_; }
    __host__ __device__ bool next(int i, Unit& u) const {
        const long L = (long)i * G + c; if (L >= nwg) return false;
        int wgid = (int)L; { const int q = nwg / NXCD, r = nwg % NXCD, xcd = wgid % NXCD, off = wgid / NXCD; wgid = (xcd < r ? xcd * (q + 1) : r * (q + 1) + (xcd - r) * q) + off; }
        const int nig = WGM * nN, gid = wgid / nig, fm = gid * WGM, gsz = (nM - fm) < WGM ? (nM - fm) : WGM;
        u.pm = fm + ((wgid % nig) % gsz); u.pn = (wgid % nig) / gsz; return true;
    }
    __device__ __forceinline__ void a_ready(const Unit&) const {}
    __device__ __forceinline__ void done(const Unit&) const {}
};

__device__ __forceinline__ unsigned cvt_pk_bf16(float lo, float hi) { unsigned r; asm volatile("v_cvt_pk_bf16_f32 %0, %1, %2" : "=v"(r) : "v"(lo), "v"(hi)); return r; }

struct EpiBf16 {
    static constexpr bool PERM = true, AFTER_DRAIN = false;
    bf16_t* O; int ldc;
    __device__ __forceinline__ void operator()(const f32x4 (&acc)[2][2][4][2], const Unit& u, int wr, int wc, int fr, int fq) const {
        const int row0 = u.pm * BM + wr * 64 + fr; const int col0 = u.pn * BM + wc * 32 + 8 * fq;
#pragma unroll
        for (int ai = 0; ai < 2; ++ai)
#pragma unroll
            for (int m = 0; m < 4; ++m) { bf16_t* rowp = O + (size_t)(row0 + ai * HALF + m * 16) * ldc + col0;
#pragma unroll
                for (int bj = 0; bj < 2; ++bj) { const f32x4 v0 = acc[ai][bj][m][0], v1 = acc[ai][bj][m][1];
                    u32x4 w; w.x = cvt_pk_bf16(v0[0], v0[1]); w.y = cvt_pk_bf16(v0[2], v0[3]); w.z = cvt_pk_bf16(v1[0], v1[1]); w.w = cvt_pk_bf16(v1[2], v1[3]);
                    *(u32x4*)(rowp + bj * HALF) = w; } }
    }
};
struct EpiProj {
    static constexpr bool PERM = true, AFTER_DRAIN = false;
    bf16_t* O; float* dtraw;
    __device__ __forceinline__ void operator()(const f32x4 (&acc)[2][2][4][2], const Unit& u, int wr, int wc, int fr, int fq) const {
        const int row0 = u.pm * BM + wr * 64 + fr;
        if (u.pn < 14) { const int col0 = u.pn * BM + wc * 32 + 8 * fq;
#pragma unroll
            for (int ai = 0; ai < 2; ++ai)
#pragma unroll
                for (int m = 0; m < 4; ++m) { bf16_t* rowp = O + (size_t)(row0 + ai * HALF + m * 16) * 3584 + col0;
#pragma unroll
                    for (int bj = 0; bj < 2; ++bj) { const f32x4 v0 = acc[ai][bj][m][0], v1 = acc[ai][bj][m][1];
                        u32x4 w; w.x = cvt_pk_bf16(v0[0], v0[1]); w.y = cvt_pk_bf16(v0[2], v0[3]); w.z = cvt_pk_bf16(v1[0], v1[1]); w.w = cvt_pk_bf16(v1[2], v1[3]);
                        *(u32x4*)(rowp + bj * HALF) = w; } }
        } else if (wc == 0) {
#pragma unroll
            for (int ai = 0; ai < 2; ++ai)
#pragma unroll
                for (int m = 0; m < 4; ++m) { float* rp = dtraw + (size_t)(row0 + ai * HALF + m * 16) * 32 + 8 * fq;
                    *(f32x4*)rp = acc[ai][0][m][0]; *(f32x4*)(rp + 4) = acc[ai][0][m][1]; }
        }
    }
};

__device__ __forceinline__ float dpp_ror1(float x) { return __builtin_bit_cast(float, __builtin_amdgcn_update_dpp(0, __builtin_bit_cast(int, x), 0x121, 0xf, 0xf, false)); }
__device__ __forceinline__ float dpp_ror15(float x) { return __builtin_bit_cast(float, __builtin_amdgcn_update_dpp(0, __builtin_bit_cast(int, x), 0x12f, 0xf, 0xf, false)); }
__device__ __forceinline__ float gelu_tanh_f(float x) { const float u = 0.7978845608028654f * (x + 0.044715f * x * x * x); const float t = 1.f - 2.f / (1.f + __expf(2.f * u)); return 0.5f * x * (1.f + t); }
struct EpiGlu {
    static constexpr bool PERM = true, AFTER_DRAIN = false;
    bf16_t* act; float* E; const float* cw; const float* cbias; PG8_LAS unsigned char* xl;
    __device__ __forceinline__ void operator()(const f32x4 (&acc)[2][2][4][2], const Unit& u, int wr, int wc, int fr, int fq) const {
        const int cl = wc * 32 + 8 * fq, ch = u.pn * 128 + cl;
        PG8_LAS float* X = (PG8_LAS float*)xl;
#pragma unroll
        for (int ai = 0; ai < 2; ++ai) { const int rb = ai * 2 + wr;
#pragma unroll
            for (int n = 0; n < 2; ++n) { const f32x4 top = acc[ai][0][0][n], bot = acc[ai][0][3][n]; f32x4 sel;
                sel[0] = fr == 0 ? top[0] : bot[0]; sel[1] = fr == 0 ? top[1] : bot[1]; sel[2] = fr == 0 ? top[2] : bot[2]; sel[3] = fr == 0 ? top[3] : bot[3];
                if (fr == 0 || fr == 15) *(PG8_LAS f32x4*)(X + (rb * 2 + (fr == 15 ? 1 : 0)) * 128 + cl + 4 * n) = sel; } }
        float* Ep = E + (size_t)u.pm * 6 * 5632 + ch;
#pragma unroll
        for (int n = 0; n < 2; ++n) { const f32x4 g0 = acc[0][0][0][n], g1 = acc[1][0][3][n], v0 = acc[0][1][0][n], v1 = acc[1][1][3][n]; f32x4 gs, vs;
#pragma unroll
            for (int j = 0; j < 4; ++j) { gs[j] = wr ? g1[j] : g0[j]; vs[j] = wr ? v1[j] : v0[j]; }
            const bool gc = wr ? (fr >= 14) : (fr < 2); const int gi = wr ? fr - 12 : fr;
            if (gc) *(f32x4*)(Ep + (size_t)gi * 5632 + 4 * n) = gs;
            if (wr ? (fr == 15) : (fr == 0)) *(f32x4*)(Ep + (size_t)(4 + wr) * 5632 + 4 * n) = vs; }
        asm volatile("s_waitcnt lgkmcnt(0)" ::: "memory"); __builtin_amdgcn_s_barrier(); asm volatile("" ::: "memory");
#pragma unroll
        for (int n = 0; n < 2; ++n) {
            const f32x4 w0 = *(const f32x4*)(cw + ch + 4 * n), w1 = *(const f32x4*)(cw + 5632 + ch + 4 * n), w2 = *(const f32x4*)(cw + 2 * 5632 + ch + 4 * n), bb = *(const f32x4*)(cbias + ch + 4 * n);
#pragma unroll
            for (int ai = 0; ai < 2; ++ai) { const int rb = ai * 2 + wr;
                const f32x4 xp = rb > 0 ? *(const PG8_LAS f32x4*)(X + ((rb - 1) * 2 + 1) * 128 + cl + 4 * n) : (f32x4){0.f, 0.f, 0.f, 0.f};
                const f32x4 xn = rb < 3 ? *(const PG8_LAS f32x4*)(X + ((rb + 1) * 2 + 0) * 128 + cl + 4 * n) : (f32x4){0.f, 0.f, 0.f, 0.f};
#pragma unroll
                for (int m = 0; m < 4; ++m) { float o[4]; const f32x4 g = acc[ai][0][m][n], v = acc[ai][1][m][n];
#pragma unroll
                    for (int j = 0; j < 4; ++j) {
                        const float up1 = dpp_ror1(g[j]), dn1 = dpp_ror15(g[j]);
                        const float pmv = (m > 0) ? dpp_ror1(acc[ai][0][m > 0 ? m - 1 : 0][n][j]) : xp[j];
                        const float nmv = (m < 3) ? dpp_ror15(acc[ai][0][m < 3 ? m + 1 : 3][n][j]) : xn[j];
                        const float prev = fr ? up1 : pmv, next = (fr < 15) ? dn1 : nmv;
                        const float a = bb[j] + w0[j] * prev + w1[j] * g[j] + w2[j] * next;
                        o[j] = gelu_tanh_f(a) * v[j]; }
                    u32x2 w; w.x = cvt_pk_bf16(o[0], o[1]); w.y = cvt_pk_bf16(o[2], o[3]);
                    *(u32x2*)(act + (size_t)(u.pm * BM + ai * HALF + wr * 64 + m * 16 + fr) * 5632 + ch + 4 * n) = w; }
                asm volatile("" ::: "memory"); } }
    }
};
struct EpiF32 {
    static constexpr bool PERM = false, AFTER_DRAIN = false;
    float* out; int ldc;
    __device__ __forceinline__ void operator()(const f32x4 (&acc)[2][2][4][2], const Unit& u, int wr, int wc, int fr, int fq) const {
        const int col0 = u.pn * BM + wc * 32 + 4 * fq;
#pragma unroll
        for (int ai = 0; ai < 2; ++ai)
#pragma unroll
            for (int m = 0; m < 4; ++m) { const size_t off = (size_t)(u.pm * BM + ai * HALF + wr * 64 + m * 16 + fr) * ldc + col0;
#pragma unroll
                for (int bj = 0; bj < 2; ++bj)
#pragma unroll
                    for (int n = 0; n < 2; ++n) *(f32x4*)(out + off + bj * HALF + n * 16) = acc[ai][bj][m][n]; }
    }
};
struct EpiGate {
    static constexpr bool PERM = false, AFTER_DRAIN = false;
    float* out; const bf16_t* pp; int ldc;
    __device__ __forceinline__ void operator()(const f32x4 (&acc)[2][2][4][2], const Unit& u, int wr, int wc, int fr, int fq) const {
        const int col0 = u.pn * BM + wc * 32 + 4 * fq;
#pragma unroll
        for (int ai = 0; ai < 2; ++ai)
#pragma unroll
            for (int m = 0; m < 4; ++m) { const size_t off = (size_t)(u.pm * BM + ai * HALF + wr * 64 + m * 16 + fr) * ldc + col0;
#pragma unroll
                for (int bj = 0; bj < 2; ++bj)
#pragma unroll
                    for (int n = 0; n < 2; ++n) { const u32x2 pv = *(const u32x2*)(pp + off + bj * HALF + n * 16); const f32x4 a = acc[ai][bj][m][n]; f32x4 o;
                        o[0] = __uint_as_float(pv.x << 16) / (1.f + __expf(-a[0])); o[1] = __uint_as_float(pv.x & 0xffff0000u) / (1.f + __expf(-a[1]));
                        o[2] = __uint_as_float(pv.y << 16) / (1.f + __expf(-a[2])); o[3] = __uint_as_float(pv.y & 0xffff0000u) / (1.f + __expf(-a[3]));
                        *(f32x4*)(out + off + bj * HALF + n * 16) = o; } }
    }
};

template <class Epi, class Sched, bool ALIGN_EPI = false, bool SP2 = false>
__device__ __forceinline__ void gemm_phase(PG8_LAS unsigned char* lds, const Gemm g, const Sched& S, const Epi& E) {
    int tid_ = threadIdx.x; asm volatile("" : "+v"(tid_));
    const int tid = tid_, wid = __builtin_amdgcn_readfirstlane(tid >> 6), lane = tid & 63, wr = wid >> 2, wc = wid & 3, fr = lane & 15, fq = lane >> 4;
    const int K = g.K, nt = K / BK;
    unsigned voffA[2], voffB[2];
#pragma unroll
    for (int i = 0; i < 2; ++i) { int R, C; stage_rc(tid * 16 + i * 8192, R, C); const int Rb = Epi::PERM ? ((R & ~31) + perm32(R & 31)) : R;
        voffA[i] = (unsigned)(R * g.lda + C) * 2u; voffB[i] = (unsigned)(Rb * g.ldb + C) * 2u; }
    const size_t kstep = (size_t)(BK * 2);
    const size_t hstepA = (size_t)HALF * g.lda * 2, hstepB = (size_t)HALF * g.ldb * 2;
    const unsigned ldsw = (unsigned)wid * 1024u;
    const int aoff = lds_byte(wr * 64 + fr, fq * 8), boff = lds_byte(wc * 32 + fr, fq * 8);
#define PG8_SA(b, h) (((b) * 2 + (h)) * HTB)
#define PG8_SB(b, h) ((4 + (b) * 2 + (h)) * HTB)
#define PG8_STAGE(bufoff, gbase, voff) do { _Pragma("unroll") for (int _i = 0; _i < 2; ++_i) \
        __builtin_amdgcn_global_load_lds((const unsigned*)((const char*)(gbase) + (voff)[_i]), (PG8_LAS unsigned*)(lds + (bufoff) + ldsw + _i * 8192), 16, 0, 0); } while (0)
#define PG8_LDA(dst, b, h) do { _Pragma("unroll") for (int m = 0; m < 4; ++m) _Pragma("unroll") for (int k = 0; k < 2; ++k) dst[m][k] = *(const PG8_LAS bf16x8*)(lds + PG8_SA(b, h) + aoff + m * 2048 + k * 1024); } while (0)
#define PG8_LDB(dst, b, h) do { _Pragma("unroll") for (int n = 0; n < 2; ++n) _Pragma("unroll") for (int k = 0; k < 2; ++k) dst[n][k] = *(const PG8_LAS bf16x8*)(lds + PG8_SB(b, h) + boff + n * 2048 + k * 1024); } while (0)
#define PG8_MMA(ai, bj, At, Bt) do { __builtin_amdgcn_s_setprio(1); _Pragma("unroll") for (int m = 0; m < 4; ++m) _Pragma("unroll") for (int n = 0; n < 2; ++n) _Pragma("unroll") for (int k = 0; k < 2; ++k) \
        acc[ai][bj][m][n] = __builtin_amdgcn_mfma_f32_16x16x32_bf16(Bt[n][k], At[m][k], acc[ai][bj][m][n], 0, 0, 0); __builtin_amdgcn_s_setprio(0); } while (0)
#define PG8_WAIT_V(n) asm volatile("s_waitcnt vmcnt(" #n ")" ::: "memory")
#define PG8_WAIT_L(n) asm volatile("s_waitcnt lgkmcnt(" #n ")" ::: "memory")
#define PG8_BAR __builtin_amdgcn_s_barrier()
#define PG8_SCHED __builtin_amdgcn_sched_barrier(0)
    Unit cur, nxt; int ui = 0;
    if (!S.next(0, cur)) return;
    f32x4 acc[2][2][4][2];
#pragma unroll
    for (int a = 0; a < 2; ++a)
#pragma unroll
        for (int b = 0; b < 2; ++b)
#pragma unroll
            for (int m = 0; m < 4; ++m)
#pragma unroll
                for (int n = 0; n < 2; ++n) acc[a][b][m][n] = (f32x4){0.f, 0.f, 0.f, 0.f};
    bf16x8 At[4][2], B0[2][2], B1[2][2];
    const char* cA = g.a_ptr(cur); const char* cB = g.b_ptr(cur);
    S.a_ready(cur);
    if constexpr (SP2) {
        PG8_STAGE(PG8_SB(0, 0), cB, voffB); PG8_STAGE(PG8_SB(0, 1), cB + hstepB, voffB); PG8_STAGE(PG8_SA(0, 0), cA, voffA); PG8_STAGE(PG8_SA(0, 1), cA + hstepA, voffA);
        if (wr == 1) PG8_BAR;
        PG8_WAIT_V(2); PG8_BAR;
        PG8_STAGE(PG8_SB(1, 0), cB + kstep, voffB); PG8_STAGE(PG8_SA(1, 0), cA + kstep, voffA); PG8_STAGE(PG8_SB(1, 1), cB + hstepB + kstep, voffB);
        PG8_WAIT_V(6); PG8_BAR;
    } else {
        PG8_STAGE(PG8_SB(0, 0), cB, voffB); PG8_STAGE(PG8_SA(0, 0), cA, voffA); PG8_STAGE(PG8_SB(0, 1), cB + hstepB, voffB); PG8_STAGE(PG8_SA(0, 1), cA + hstepA, voffA);
        if (wr == 1) PG8_BAR;
        PG8_WAIT_V(4); PG8_BAR;
        PG8_STAGE(PG8_SB(1, 0), cB + kstep, voffB); PG8_STAGE(PG8_SA(1, 0), cA + kstep, voffA); PG8_STAGE(PG8_SB(1, 1), cB + hstepB + kstep, voffB);
        PG8_WAIT_V(6); PG8_BAR;
    }
    for (;;) {
        const bool has_next = S.next(ui + 1, nxt);
        const char* nA = has_next ? g.a_ptr(nxt) : cA; const char* nB = has_next ? g.b_ptr(nxt) : cB;
        for (int t = 0; t < nt; t += 2) {
            const bool last = (t == nt - 2);
            const char* a1 = cA + (size_t)(t + 1) * kstep;
            const char* a2 = last ? nA : cA + (size_t)(t + 2) * kstep; const char* b2 = last ? nB : cB + (size_t)(t + 2) * kstep;
            const char* a3 = a2 + kstep; const char* b3 = b2 + kstep;
            if (last && has_next) S.a_ready(nxt);
            if constexpr (SP2) {
            PG8_LDB(B0, 0, 0); PG8_LDB(B1, 0, 1); PG8_SCHED; PG8_LDA(At, 0, 0); PG8_STAGE(PG8_SA(1, 1), a1 + hstepA, voffA);
            PG8_WAIT_V(8); PG8_WAIT_L(0); PG8_BAR; PG8_MMA(0, 0, At, B0); PG8_MMA(0, 1, At, B1); PG8_BAR; PG8_SCHED;
            PG8_LDA(At, 0, 1); PG8_STAGE(PG8_SB(0, 0), b2, voffB); PG8_STAGE(PG8_SB(0, 1), b2 + hstepB, voffB); PG8_STAGE(PG8_SA(0, 0), a2, voffA);
            PG8_WAIT_V(8); PG8_WAIT_L(0); PG8_BAR; PG8_MMA(1, 0, At, B0); PG8_MMA(1, 1, At, B1); PG8_BAR; PG8_SCHED;
            PG8_LDB(B0, 1, 0); PG8_LDB(B1, 1, 1); PG8_SCHED; PG8_LDA(At, 1, 0); PG8_STAGE(PG8_SA(0, 1), a2 + hstepA, voffA);
            PG8_WAIT_V(8); PG8_WAIT_L(0); PG8_BAR; PG8_MMA(0, 0, At, B0); PG8_MMA(0, 1, At, B1); PG8_BAR; PG8_SCHED;
            PG8_LDA(At, 1, 1); PG8_STAGE(PG8_SB(1, 0), b3, voffB); PG8_STAGE(PG8_SB(1, 1), b3 + hstepB, voffB); PG8_STAGE(PG8_SA(1, 0), a3, voffA);
            PG8_WAIT_V(8); PG8_WAIT_L(0); PG8_BAR; PG8_MMA(1, 0, At, B0); PG8_MMA(1, 1, At, B1); PG8_BAR; PG8_SCHED;
            } else {
            PG8_LDB(B0, 0, 0); PG8_SCHED; PG8_LDA(At, 0, 0); PG8_STAGE(PG8_SA(1, 1), a1 + hstepA, voffA);
            PG8_WAIT_L(8); PG8_BAR; PG8_WAIT_L(0); PG8_MMA(0, 0, At, B0); PG8_BAR; PG8_SCHED;
            PG8_LDB(B1, 0, 1); PG8_STAGE(PG8_SB(0, 0), b2, voffB);
            PG8_BAR; PG8_WAIT_L(0); PG8_MMA(0, 1, At, B1); PG8_BAR;
            PG8_LDA(At, 0, 1); PG8_STAGE(PG8_SA(0, 0), a2, voffA);
            PG8_BAR; PG8_WAIT_L(0); PG8_MMA(1, 0, At, B0); PG8_BAR; PG8_SCHED;
            PG8_STAGE(PG8_SB(0, 1), b2 + hstepB, voffB);
            PG8_WAIT_V(6); PG8_BAR; PG8_MMA(1, 1, At, B1); PG8_BAR;
            PG8_LDB(B0, 1, 0); PG8_SCHED; PG8_LDA(At, 1, 0); PG8_STAGE(PG8_SA(0, 1), a2 + hstepA, voffA);
            PG8_WAIT_L(8); PG8_BAR; PG8_WAIT_L(0); PG8_MMA(0, 0, At, B0); PG8_BAR; PG8_SCHED;
            PG8_LDB(B1, 1, 1); PG8_STAGE(PG8_SB(1, 0), b3, voffB);
            PG8_BAR; PG8_WAIT_L(0); PG8_MMA(0, 1, At, B1); PG8_BAR;
            PG8_LDA(At, 1, 1); PG8_STAGE(PG8_SA(1, 0), a3, voffA);
            PG8_BAR; PG8_WAIT_L(0); PG8_MMA(1, 0, At, B0); PG8_BAR; PG8_SCHED;
            PG8_STAGE(PG8_SB(1, 1), b3 + hstepB, voffB);
            PG8_WAIT_V(6); PG8_BAR; PG8_MMA(1, 1, At, B1); PG8_BAR;
            }
        }
        if constexpr (ALIGN_EPI) { if (wr == 0) PG8_BAR; }
        if constexpr (!Epi::AFTER_DRAIN) { E(acc, cur, wr, wc, fr, fq); S.done(cur); }
        if (!has_next) break;
#pragma unroll
        for (int a = 0; a < 2; ++a)
#pragma unroll
            for (int b = 0; b < 2; ++b)
#pragma unroll
                for (int m = 0; m < 4; ++m)
#pragma unroll
                    for (int n = 0; n < 2; ++n) acc[a][b][m][n] = (f32x4){0.f, 0.f, 0.f, 0.f};
        cur = nxt; cA = nA; cB = nB; ++ui;
        if constexpr (ALIGN_EPI) { if (wr == 1) PG8_BAR; }
    }
    PG8_WAIT_V(0);
    if constexpr (!ALIGN_EPI) { if (wr == 0) PG8_BAR; }
    PG8_BAR;
    if constexpr (Epi::AFTER_DRAIN) { E.fused(acc, cur, wr, wc, fr, fq, lds, wid, lane); S.done(cur); }
#undef PG8_SA
#undef PG8_SB
#undef PG8_STAGE
#undef PG8_LDA
#undef PG8_LDB
#undef PG8_MMA
#undef PG8_WAIT_V
#undef PG8_WAIT_L
#undef PG8_BAR
#undef PG8_SCHED
}
}

constexpr int NWAVES = 8;
constexpr int L = 8192, DM = 2048, DSSD = 1024, NH = 16, NCH = 64  , DFF = 5632, DPLE = 256;
constexpr int NPROJ = 3584;
constexpr int NPROJ_PAD = 3840;
constexpr float EPS = 1e-6f;
#ifndef MK_N_LAUNCHES
#define MK_N_LAUNCHES 1
#endif
constexpr int N_PHASES = 14;
#ifndef DUP_MASK
#define DUP_MASK 0u
#endif

constexpr size_t MiB = 1u << 20;
constexpr size_t WS_WDOWN = 1 * MiB, WS_WUP = 23 * MiB, WS_HN = 67 * MiB, WS_PP = 99 * MiB, WS_WGATE = 131 * MiB, WS_WPLE = 139 * MiB, WS_WPOOL = 140 * MiB;
constexpr size_t WS_UP = 141 * MiB;
constexpr size_t WS_WIN = 141 * MiB, WS_WOUT = 156 * MiB, WS_PROJ = 164 * MiB, WS_YCAT = 224 * MiB, WS_MIXED = 256 * MiB, WS_XST = 272 * MiB;
constexpr size_t WS_BM = 288 * MiB, WS_BMT = 292 * MiB, WS_CM = 296 * MiB, WS_TAB = 300 * MiB, WS_DTRAW = 302 * MiB, WS_HIN = 304 * MiB, WS_PBF = 336 * MiB;
constexpr size_t WS_STATES = 67 * MiB;
constexpr size_t WS_MIX = 256 * MiB;
constexpr size_t WS_FF = 23 * MiB;
constexpr size_t WS_ACT = 141 * MiB;
constexpr size_t WS_EDGE = 229 * MiB;
constexpr size_t WS_HN3 = 234 * MiB, WS_T = 266 * MiB;
constexpr size_t WS_END = 340 * MiB;

constexpr int LDS_BYTES = 155648;
constexpr int LDS_XCH = 131072, LDS_MISC = 155648 - 256;
constexpr int CW_BAR = 4096;
constexpr size_t CTL_ZERO_BYTES = 65536;

#define LAS __attribute__((address_space(3)))
typedef unsigned short bf16;
typedef unsigned v4u __attribute__((ext_vector_type(4)));
typedef unsigned v2u __attribute__((ext_vector_type(2)));
typedef float f32x4 __attribute__((ext_vector_type(4)));
typedef float f32x2 __attribute__((ext_vector_type(2)));
typedef short bf16x8 __attribute__((ext_vector_type(8)));
#define LDS_WAIT() asm volatile("s_waitcnt lgkmcnt(0)" ::: "memory")
__device__ __forceinline__ unsigned f2bf(float f) { unsigned u = __builtin_bit_cast(unsigned, f); return (u + 0x7fffu + ((u >> 16) & 1u)) >> 16; }
__device__ __forceinline__ unsigned pk2(float lo, float hi) { return f2bf(lo) | (f2bf(hi) << 16); }
__device__ __forceinline__ float bf2f(bf16 b) { return __uint_as_float((unsigned)b << 16); }
__device__ __forceinline__ float bflo(unsigned u) { return __uint_as_float(u << 16); }
__device__ __forceinline__ float bfhi(unsigned u) { return __uint_as_float(u & 0xffff0000u); }
__device__ __forceinline__ float wave_sum(float v) {
#pragma unroll
    for (int o = 1; o < 64; o <<= 1) v += __shfl_xor(v, o);
    return v;
}
__device__ __forceinline__ float dot4(f32x4 a) { return (a.x * a.x + a.y * a.y) + (a.z * a.z + a.w * a.w); }

#define XB_TMO      128
#define XB_XCNT(j)  (256  + 64 * (j))
#define XB_XSUB(j)  (1280 + 64 * (j))
#define XB_XGEN(j)  (2304 + 64 * (j))
#define XB_TOP      3328
#define XB_TOPGEN   3392
#define XCD_BAR_WORDS 3456
#define XB_SPIN_CAP (1u << 18)

__device__ __forceinline__ unsigned xb_ld(unsigned* p)              { return __hip_atomic_load(p, __ATOMIC_RELAXED, __HIP_MEMORY_SCOPE_AGENT); }
__device__ __forceinline__ unsigned xb_add(unsigned* p, unsigned v) { return __hip_atomic_fetch_add(p, v, __ATOMIC_RELAXED, __HIP_MEMORY_SCOPE_AGENT); }
__device__ __forceinline__ unsigned xb_xcc_id() { return (unsigned)__builtin_amdgcn_s_getreg((3 << 11) | 20) & 0xFu; }
#define XB_SPIN(cond, bar) do { unsigned _sp = 0; while (cond) { __builtin_amdgcn_s_sleep(1); \
    if ((++_sp & 255u) == 0u) { if (xb_ld(&(bar)[XB_TMO])) break; if (_sp > XB_SPIN_CAP) { atomicAdd(&(bar)[XB_TMO], 1u); break; } } } } while (0)

struct XcdBarrier {
    unsigned* bar; unsigned x;
    volatile LAS unsigned* st;
};

__device__ __forceinline__ XcdBarrier xcd_barrier_post(unsigned* bar, volatile LAS unsigned* st) {
    XcdBarrier b; b.bar = bar; b.x = xb_xcc_id(); b.st = st;
    if (threadIdx.x == 0) (void)xb_add(&bar[XB_XCNT(b.x)], 1u);
    return b;
}
__device__ __forceinline__ void xcd_barrier_complete(unsigned* bar, unsigned x, unsigned& nloc, unsigned& nx) {
    const unsigned G = gridDim.x * gridDim.y * gridDim.z;
    unsigned sum, cnt, mine, sp = 0u;
    for (;;) {
        sum = 0u; cnt = 0u; mine = 0u;
#pragma unroll
        for (unsigned j = 0; j < 16; ++j) { const unsigned c = xb_ld(&bar[XB_XCNT(j)]); sum += c; cnt += (c > 0u) ? 1u : 0u; mine = (j == x) ? c : mine; }
        if (sum == G) break;
        __builtin_amdgcn_s_sleep(1);
        if ((++sp & 255u) == 0u) { if (xb_ld(&bar[XB_TMO])) break; if (sp > XB_SPIN_CAP) { atomicAdd(&bar[XB_TMO], 1u); break; } }
    }
    nloc = mine > 0u ? mine : 1u; nx = cnt > 0u ? cnt : 1u;
}

__device__ __forceinline__ void xcd_barrier(const XcdBarrier& b) {
    asm volatile("s_waitcnt vmcnt(0)" ::: "memory");
    __syncthreads();
    if (threadIdx.x == 0) {
        unsigned* bar = b.bar;
        __builtin_amdgcn_s_waitcnt(0);
        unsigned nloc = b.st[0], nx = b.st[1];
        if (nloc == 0u) { xcd_barrier_complete(bar, b.x, nloc, nx); b.st[0] = nloc; b.st[1] = nx; }
        const unsigned old = xb_add(&bar[XB_XSUB(b.x)], 1u);
        const unsigned gen = old / nloc;
        if (old + 1u == (gen + 1u) * nloc) {
            __builtin_amdgcn_fence(__ATOMIC_RELEASE, "agent");
            asm volatile("s_waitcnt vmcnt(0)" ::: "memory");
            const unsigned og = xb_add(&bar[XB_TOP], 1u);
            const unsigned tg = og / nx;
            if (og + 1u == (tg + 1u) * nx) xb_add(&bar[XB_TOPGEN], 1u);
            else XB_SPIN(xb_ld(&bar[XB_TOPGEN]) == tg, bar);
            __builtin_amdgcn_fence(__ATOMIC_ACQUIRE, "agent");
            xb_add(&bar[XB_XGEN(b.x)], 1u);
            asm volatile("s_waitcnt vmcnt(0)" ::: "memory");
        } else {
            XB_SPIN(xb_ld(&bar[XB_XGEN(b.x)]) == gen, bar);
            __builtin_amdgcn_fence(__ATOMIC_ACQUIRE, "agent");
            asm volatile("s_waitcnt vmcnt(0)" ::: "memory");
        }
    }
    __syncthreads();
}

struct Ptrs {
    const float *x, *p, *mix_norm_pre, *mix_norm_post, *w_in, *ssd_conv_w, *ssd_conv_b, *ssd_dt_bias, *ssd_a_log, *ssd_d, *ssd_norm, *pool_w, *pool_scale, *w_out,
        *ffn_norm_pre, *ffn_norm_post, *w_ffn_up, *ffn_conv_w, *ffn_conv_b, *w_ffn_down, *ple_norm_pre, *w_ple_gate, *w_ple, *ple_norm_post;
    float* out; unsigned char* ws;
};

__device__ __forceinline__ void p0_transpose_item(const float* W, int N, bf16* WT, int ldt, int drow0, int k0, int n0, const float* scale, LAS float* scr, int lane) {
#pragma unroll 8
    for (int i = 0; i < 32; ++i) { const int kk = 2 * i + (lane >> 5); scr[kk * 33 + (lane & 31)] = W[(size_t)(k0 + kk) * N + n0 + (lane & 31)]; }
    LDS_WAIT(); asm volatile("" ::: "memory");
    const int c = lane & 7;
#pragma unroll
    for (int j = 0; j < 4; ++j) { const int n = (lane >> 3) + 8 * j; const LAS float* s = scr + (8 * c) * 33 + n; const float sc = scale ? scale[n0 + n] : 1.f;
        v4u o; o.x = pk2(s[0 * 33] * sc, s[1 * 33] * sc); o.y = pk2(s[2 * 33] * sc, s[3 * 33] * sc); o.z = pk2(s[4 * 33] * sc, s[5 * 33] * sc); o.w = pk2(s[6 * 33] * sc, s[7 * 33] * sc);
        *(v4u*)(WT + (size_t)(drow0 + n) * ldt + k0 + 8 * c) = o; }
    LDS_WAIT(); asm volatile("" ::: "memory");
}
__device__ __forceinline__ void rms_row_to_bf16(const float* xrow, const float* g, bf16* orow, int lane) {
    const f32x4* xr = (const f32x4*)xrow + lane; f32x4 v[8]; float s = 0.f;
#pragma unroll
    for (int j = 0; j < 8; ++j) { v[j] = xr[64 * j]; s += dot4(v[j]); }
    const float r = 1.f / sqrtf(wave_sum(s) * (1.f / DM) + EPS);
#pragma unroll
    for (int j = 0; j < 8; ++j) { const f32x4 gv = ((const f32x4*)g)[lane + 64 * j]; const f32x4 o = v[j] * r * gv;
        *(v2u*)(orow + (size_t)(lane + 64 * j) * 4) = (v2u){pk2(o.x, o.y), pk2(o.z, o.w)}; }
}
__device__ __forceinline__ void p0_prologue(const Ptrs& P, LAS unsigned char* lds, int G, int wave, int lane) {
    LAS float* scr = (LAS float*)(lds + wave * 16384);
    const int gw = blockIdx.x * NWAVES + wave, NGW = G * NWAVES;
    bf16* w_inT = (bf16*)(P.ws + WS_WIN); bf16* w_outT = (bf16*)(P.ws + WS_WOUT); bf16* w_upT = (bf16*)(P.ws + WS_WUP); bf16* w_downT = (bf16*)(P.ws + WS_WDOWN);
    bf16* w_gateT = (bf16*)(P.ws + WS_WGATE); bf16* w_pleT = (bf16*)(P.ws + WS_WPLE); bf16* w_poolT = (bf16*)(P.ws + WS_WPOOL);
    constexpr int I_IN = 32 * 113, I_OUT = 32 * 64, I_UP = 32 * 352, I_DOWN = 88 * 64, I_GATE = 32 * 64, I_PLE = 4 * 64, I_POOL = 4 * 32;
    constexpr int NITEMS = I_IN + I_OUT + I_UP + I_DOWN + I_GATE + I_PLE + I_POOL;
    for (int it = gw; it < NITEMS; it += NGW) {
        int r = it;
        if (r < I_IN) { const int kb = r / 113, nb = r % 113; const int drow = nb < 80 ? nb * 32 : (nb == 80 ? 3584 : (nb - 1) * 32);
            p0_transpose_item(P.w_in, 3616, w_inT, DM, drow, kb * 64, nb * 32, nullptr, scr, lane); continue; } r -= I_IN;
        if (r < I_OUT) { const int kb = r / 64, nb = r % 64; p0_transpose_item(P.w_out, DM, w_outT, DM, nb * 32, kb * 64, nb * 32, nullptr, scr, lane); continue; } r -= I_OUT;
        if (r < I_UP) { const int kb = r / 352, nb = r % 352; const int isv = nb >= 176, c0 = (nb - isv * 176) * 32; const int drow = (c0 >> 7) * 256 + isv * 128 + (c0 & 127);
            p0_transpose_item(P.w_ffn_up, 2 * DFF, w_upT, DM, drow, kb * 64, nb * 32, nullptr, scr, lane); continue; } r -= I_UP;
        if (r < I_DOWN) { const int kb = r / 64, nb = r % 64; p0_transpose_item(P.w_ffn_down, DM, w_downT, DFF, nb * 32, kb * 64, nb * 32, nullptr, scr, lane); continue; } r -= I_DOWN;
        if (r < I_GATE) { const int kb = r / 64, nb = r % 64; p0_transpose_item(P.w_ple_gate, DM, w_gateT, DM, nb * 32, kb * 64, nb * 32, nullptr, scr, lane); continue; } r -= I_GATE;
        if (r < I_PLE) { const int kb = r / 64, nb = r % 64; p0_transpose_item(P.w_ple, DM, w_pleT, DPLE, nb * 32, kb * 64, nb * 32, nullptr, scr, lane); continue; } r -= I_PLE;
        { const int gi = r / 32, q = r % 32, kb = q / 8, nb = q % 8;
          p0_transpose_item(P.pool_w + (size_t)gi * 65536, 256, w_poolT + (size_t)gi * 65536, 256, nb * 32, kb * 64, nb * 32, P.pool_scale + gi * 256, scr, lane); }
    }
    { v4u* zp = (v4u*)(w_inT + (size_t)3616 * DM); const int nz = 224 * DM * 2 / 16;
      for (int i = gw * 64 + lane; i < nz; i += NGW * 64) zp[i] = (v4u){0u, 0u, 0u, 0u}; }
    { const f32x4* ps = (const f32x4*)P.p; v2u* pd = (v2u*)(P.ws + WS_PBF); const int np = L * DPLE / 4;
      for (int i = gw * 64 + lane; i < np; i += NGW * 64) { const f32x4 v = ps[i]; pd[i] = (v2u){pk2(v.x, v.y), pk2(v.z, v.w)}; } }
    bf16* hn = (bf16*)(P.ws + WS_HN);
    for (int m = gw; m < L; m += NGW) rms_row_to_bf16(P.x + (size_t)m * DM, P.mix_norm_pre, hn + (size_t)m * DM, lane);
}

__device__ __forceinline__ float softplus_f(float x) { return fmaxf(x, 0.f) + log1pf(__expf(-fabsf(x))); }
template <int K> __device__ __forceinline__ void pool_item(const bf16* src, bf16* dst, int t0) {
    constexpr int H = K / 2, NR = 8 + K - 1;
    float v[NR];
#pragma unroll
    for (int r = 0; r < NR; ++r) { const int t = t0 - H + r; v[r] = (t >= 0 && t < L) ? bf2f(src[(size_t)t * NPROJ]) : 0.f; }
#pragma unroll
    for (int i = 0; i < 8; ++i) { const int t = t0 + i; const int lo = t - H > 0 ? t - H : 0, hi = t + H < L ? t + H : L; float s = 0.f;
#pragma unroll
        for (int r = 0; r < K; ++r) s += v[i + r];
        const float o = s / (float)(hi - lo) - v[i + H]; dst[(size_t)t * 1024] = (bf16)f2bf(o); }
}
__device__ __forceinline__ void p2_phase(const Ptrs& P, int G, int wave, int lane) {
    const int gw = blockIdx.x * NWAVES + wave, NGW = G * NWAVES;
    const bf16* proj = (const bf16*)(P.ws + WS_PROJ); const float* dtraw = (const float*)(P.ws + WS_DTRAW); float* tab = (float*)(P.ws + WS_TAB);
    bf16* xsT = (bf16*)(P.ws + WS_XST); bf16* Bm = (bf16*)(P.ws + WS_BM); bf16* BmT = (bf16*)(P.ws + WS_BMT); bf16* Cm = (bf16*)(P.ws + WS_CM); bf16* mixed = (bf16*)(P.ws + WS_MIXED);
    for (int id = gw; id < NCH * 2 * NH; id += NGW) {
        const int c = id >> 5, dir = (id >> 4) & 1, h = id & 15;
        const float bias = P.ssd_dt_bias[dir * NH + h], a = -__expf(P.ssd_a_log[dir * NH + h]);
        const int i0 = 2 * lane, i1 = 2 * lane + 1, l0 = dir ? 127 - i0 : i0, l1 = dir ? 127 - i1 : i1;
        const float dt0 = softplus_f(dtraw[(size_t)(c * 128 + l0) * 32 + dir * NH + h] + bias), dt1 = softplus_f(dtraw[(size_t)(c * 128 + l1) * 32 + dir * NH + h] + bias);
        const float da0 = dt0 * a, da1 = dt1 * a; float s = da0 + da1;
#pragma unroll
        for (int o = 1; o < 64; o <<= 1) { const float t = __shfl_up(s, o); if (lane >= o) s += t; }
        const float excl = s - (da0 + da1);
        float* ta = tab + ((size_t)(dir * NCH + c) * NH + h) * 128; float* td = tab + ((size_t)((2 + dir) * NCH + c) * NH + h) * 128;
        ta[l0] = excl + da0; ta[l1] = s; td[l0] = dt0; td[l1] = dt1;
    }
    for (int it = gw; it < 1024 * 24; it += NGW) {
        const int tb = it / 24, cb = it % 24, t0 = tb * 8, ch = cb * 64 + lane;
        const bf16* src = proj + 1024 + ch; float v[12];
#pragma unroll
        for (int r = 0; r < 12; ++r) { const int t = t0 - 2 + r; v[r] = (t >= 0 && t < L) ? bf2f(src[(size_t)t * NPROJ]) : 0.f; }
        float w[5];
#pragma unroll
        for (int j = 0; j < 5; ++j) w[j] = P.ssd_conv_w[j * 1536 + ch];
        const float b = P.ssd_conv_b[ch]; float o[8];
#pragma unroll
        for (int i = 0; i < 8; ++i) { float a = b;
#pragma unroll
            for (int j = 0; j < 5; ++j) a += w[j] * v[i + j];
            o[i] = a / (1.f + __expf(-a)); }
        const v4u pk = (v4u){pk2(o[0], o[1]), pk2(o[2], o[3]), pk2(o[4], o[5]), pk2(o[6], o[7])};
        const int c = t0 >> 7, l0 = t0 & 127;
        if (cb < 16) {
            *(v4u*)(xsT + ((size_t)((c * NH + cb) * 64 + lane)) * 128 + l0) = pk;
        } else if (cb < 20) {
            const int gn = ch - 1024, g = gn >> 7, n = gn & 127;
            *(v4u*)(BmT + ((size_t)((c * 2 + g) * 128 + n)) * 128 + l0) = pk;
#pragma unroll
            for (int i = 0; i < 8; ++i) Bm[(size_t)(t0 + i) * 256 + gn] = (bf16)f2bf(o[i]);
        } else {
            const int cn = ch - 1280;
#pragma unroll
            for (int i = 0; i < 8; ++i) Cm[(size_t)(t0 + i) * 256 + cn] = (bf16)f2bf(o[i]);
        }
    }
    for (int it = gw; it < 1024 * 16; it += NGW) {
        const int tb = it >> 4, cb = it & 15, t0 = tb * 8, ch = cb * 64 + lane, gi = cb >> 2;
        const bf16* src = proj + 2560 + ch; bf16* dst = mixed + ch;
        if (gi == 0) pool_item<2>(src, dst, t0); else if (gi == 1) pool_item<4>(src, dst, t0); else if (gi == 2) pool_item<8>(src, dst, t0); else pool_item<16>(src, dst, t0);
    }
}

__device__ __forceinline__ void p3_phase(const Ptrs& P, int G, int wave, int lane) {
    const int gw = blockIdx.x * NWAVES + wave, NGW = G * NWAVES, fr = lane & 15, fq = lane >> 4;
    const float* tab = (const float*)(P.ws + WS_TAB); const bf16* xsT = (const bf16*)(P.ws + WS_XST); const bf16* BmT = (const bf16*)(P.ws + WS_BMT); float* states = (float*)(P.ws + WS_STATES);
    for (int id = gw; id < NCH * 2 * NH; id += NGW) {
        const int c = id >> 5, dir = (id >> 4) & 1, h = id & 15, g = h >> 3;
        const float* ta = tab + ((size_t)(dir * NCH + c) * NH + h) * 128; const float* td = tab + ((size_t)((2 + dir) * NCH + c) * NH + h) * 128;
        const float a_end = dir ? ta[0] : ta[127];
        f32x4 acc[4][8];
#pragma unroll
        for (int mt = 0; mt < 4; ++mt)
#pragma unroll
            for (int nt = 0; nt < 8; ++nt) acc[mt][nt] = (f32x4){0.f, 0.f, 0.f, 0.f};
#pragma unroll 1
        for (int kk = 0; kk < 4; ++kk) {
            const int lb = kk * 32 + fq * 8;
            const f32x4 a0 = *(const f32x4*)(ta + lb), a1 = *(const f32x4*)(ta + lb + 4), d0 = *(const f32x4*)(td + lb), d1 = *(const f32x4*)(td + lb + 4);
            float w[8];
#pragma unroll
            for (int i = 0; i < 4; ++i) { w[i] = d0[i] * __expf(a_end - a0[i]); w[4 + i] = d1[i] * __expf(a_end - a1[i]); }
            bf16x8 Af[4];
#pragma unroll
            for (int mt = 0; mt < 4; ++mt) { const v4u raw = *(const v4u*)(xsT + ((size_t)((c * NH + h) * 64 + mt * 16 + fr)) * 128 + lb);
                v4u sc; sc.x = pk2(bflo(raw.x) * w[0], bfhi(raw.x) * w[1]); sc.y = pk2(bflo(raw.y) * w[2], bfhi(raw.y) * w[3]);
                sc.z = pk2(bflo(raw.z) * w[4], bfhi(raw.z) * w[5]); sc.w = pk2(bflo(raw.w) * w[6], bfhi(raw.w) * w[7]);
                Af[mt] = __builtin_bit_cast(bf16x8, sc); }
#pragma unroll
            for (int nt = 0; nt < 8; ++nt) { const bf16x8 Bf = *(const bf16x8*)(BmT + ((size_t)((c * 2 + g) * 128 + nt * 16 + fr)) * 128 + lb);
#pragma unroll
                for (int mt = 0; mt < 4; ++mt) acc[mt][nt] = __builtin_amdgcn_mfma_f32_16x16x32_bf16(Bf, Af[mt], acc[mt][nt], 0, 0, 0); }
        }
        float* so = states + ((size_t)((dir * NCH + c) * NH + h)) * 64 * 128;
#pragma unroll
        for (int mt = 0; mt < 4; ++mt)
#pragma unroll
            for (int nt = 0; nt < 8; ++nt) *(f32x4*)(so + (size_t)(mt * 16 + fr) * 128 + nt * 16 + fq * 4) = acc[mt][nt];
    }
}

__device__ __forceinline__ void p4_phase(const Ptrs& P, int G) {
    const float* tab = (const float*)(P.ws + WS_TAB); const float* states = (const float*)(P.ws + WS_STATES); bf16* hin = (bf16*)(P.ws + WS_HIN);
    for (int e = blockIdx.x * 512 + threadIdx.x; e < 2 * NH * 64 * 64; e += G * 512) {
        const int n2 = e & 63, p = (e >> 6) & 63, h = (e >> 12) & 15, dir = e >> 16;
        const size_t eo = (size_t)p * 128 + 2 * n2, cstride = (size_t)NH * 64 * 128;
        const float* sb = states + ((size_t)(dir * NCH) * NH + h) * 64 * 128 + eo; bf16* hb = hin + ((size_t)(dir * NCH) * NH + h) * 64 * 128 + eo;
        const float* ta = tab + ((size_t)(dir * NCH) * NH + h) * 128 + (dir ? 0 : 127);
        f32x2 st = (f32x2){0.f, 0.f};
#pragma unroll 1
        for (int i0 = 0; i0 < NCH; i0 += 8) {
            f32x2 sv[8]; float cd[8];
#pragma unroll
            for (int j = 0; j < 8; ++j) { const int c = dir ? NCH - 1 - (i0 + j) : i0 + j; sv[j] = *(const f32x2*)(sb + (size_t)c * cstride); cd[j] = ta[(size_t)c * NH * 128]; }
#pragma unroll
            for (int j = 0; j < 8; ++j) { const int c = dir ? NCH - 1 - (i0 + j) : i0 + j;
                *(unsigned*)(hb + (size_t)c * cstride) = pk2(st.x, st.y);
                const float d = __expf(cd[j]); st = st * d + sv[j]; }
        }
    }
}

constexpr int P5_PITCH = 272, P5_MAT = 64 * P5_PITCH, P5_STAGE = 16384, P5_Q = P5_STAGE + 6 * P5_MAT;
__device__ __forceinline__ void p5_ssd_unit(const Ptrs& P, LAS unsigned char* lds, int c, int g, int rh, int tid, int wave, int lane) {
    const int fr = lane & 15, fq = lane >> 4, rt = wave & 3, hs = wave >> 2, grt = rh * 4 + rt;
    const float* tab = (const float*)(P.ws + WS_TAB); const bf16* xsT = (const bf16*)(P.ws + WS_XST); const bf16* Bm = (const bf16*)(P.ws + WS_BM); const bf16* Cm = (const bf16*)(P.ws + WS_CM);
    const bf16* hin = (const bf16*)(P.ws + WS_HIN); const bf16* proj = (const bf16*)(P.ws + WS_PROJ); bf16* ycat = (bf16*)(P.ws + WS_YCAT);
    LAS float* T = (LAS float*)lds;
    LAS unsigned char* SB = lds + P5_STAGE;
    LAS float* Q = (LAS float*)(lds + P5_Q);
    const int t0 = c * 128, lrow = 64 * rh + 16 * rt + fr;
    const int srow0 = tid >> 4, scol = tid & 15;
    v4u R[12];
#define P5_LOAD(i) do { _Pragma("unroll") for (int k = 0; k < 12; ++k) { const int mi = k >> 1, hsel = mi / 3, mat = mi % 3, row = srow0 + 32 * (k & 1), h = g * 8 + hsel * 4 + (i); \
        const bf16* src = (mat == 0) ? xsT + ((size_t)(c * NH + h) * 64 + row) * 128 : hin + ((size_t)(((mat - 1) * NCH + c) * NH + h) * 64 + row) * 128; \
        R[k] = *(const v4u*)(src + scol * 8); } } while (0)
#define P5_STORE() do { _Pragma("unroll") for (int k = 0; k < 12; ++k) { const int mi = k >> 1, row = srow0 + 32 * (k & 1); *(LAS v4u*)(SB + mi * P5_MAT + row * P5_PITCH + scol * 16) = R[k]; } } while (0)
    __syncthreads();
    for (int idx = tid; idx < 4 * 8 * 128; idx += 512) { const int which = idx >> 10, hh = (idx >> 7) & 7, l = idx & 127; T[idx] = tab[((size_t)(which * NCH + c) * NH + g * 8 + hh) * 128 + l]; }
    bf16x8 Cf[4];
#pragma unroll
    for (int kk = 0; kk < 4; ++kk) Cf[kk] = *(const bf16x8*)(Cm + (size_t)(t0 + lrow) * 256 + g * 128 + kk * 32 + fq * 8);
    f32x4 cb[8];
#pragma unroll
    for (int st = 0; st < 8; ++st) { cb[st] = (f32x4){0.f, 0.f, 0.f, 0.f};
#pragma unroll
        for (int kk = 0; kk < 4; ++kk) { const bf16x8 Bf = *(const bf16x8*)(Bm + (size_t)(t0 + st * 16 + fr) * 256 + g * 128 + kk * 32 + fq * 8);
            cb[st] = __builtin_amdgcn_mfma_f32_16x16x32_bf16(Bf, Cf[kk], cb[st], 0, 0, 0); } }
    float sumsq = 0.f;
    bf16* yrow = ycat + (size_t)(t0 + lrow) * DM + g * 512 + hs * 256 + fq * 4;
#pragma unroll 1
    for (int i = 0; i < 4; ++i) {
        P5_LOAD(i);
        P5_STORE();
        __syncthreads();
        const int hh = hs * 4 + i, h = g * 8 + hh;
        const float alf = T[(0 * 8 + hh) * 128 + lrow], alb = T[(1 * 8 + hh) * 128 + lrow], dsk = P.ssd_d[h];
        bf16x8 Mf[4];
#pragma unroll
        for (int kk = 0; kk < 4; ++kk) { float mv[8];
#pragma unroll
            for (int hf = 0; hf < 2; ++hf) { const int st = 2 * kk + hf, s0 = st * 16 + fq * 4;
                if (st < grt) {
                    const f32x4 asf = *(const LAS f32x4*)(T + (0 * 8 + hh) * 128 + s0), dsf = *(const LAS f32x4*)(T + (2 * 8 + hh) * 128 + s0);
#pragma unroll
                    for (int r = 0; r < 4; ++r) mv[hf * 4 + r] = cb[st][r] * (__expf(fminf(alf - asf[r], 0.f)) * dsf[r]);
                } else if (st > grt) {
                    const f32x4 asb = *(const LAS f32x4*)(T + (1 * 8 + hh) * 128 + s0), dsb = *(const LAS f32x4*)(T + (3 * 8 + hh) * 128 + s0);
#pragma unroll
                    for (int r = 0; r < 4; ++r) mv[hf * 4 + r] = cb[st][r] * (__expf(fminf(alb - asb[r], 0.f)) * dsb[r]);
                } else {
                    const f32x4 asf = *(const LAS f32x4*)(T + (0 * 8 + hh) * 128 + s0), asb = *(const LAS f32x4*)(T + (1 * 8 + hh) * 128 + s0);
                    const f32x4 dsf = *(const LAS f32x4*)(T + (2 * 8 + hh) * 128 + s0), dsb = *(const LAS f32x4*)(T + (3 * 8 + hh) * 128 + s0);
#pragma unroll
                    for (int r = 0; r < 4; ++r) { const int s = s0 + r;
                        const float vf = (s <= lrow) ? __expf(fminf(alf - asf[r], 0.f)) * dsf[r] : 0.f;
                        const float vb = (s >= lrow) ? __expf(fminf(alb - asb[r], 0.f)) * dsb[r] : 0.f;
                        mv[hf * 4 + r] = cb[st][r] * (vf + vb) + ((s == lrow) ? dsk : 0.f); } } }
            const v4u pk = (v4u){pk2(mv[0], mv[1]), pk2(mv[2], mv[3]), pk2(mv[4], mv[5]), pk2(mv[6], mv[7])};
            Mf[kk] = __builtin_bit_cast(bf16x8, pk); }
        f32x4 accY[4], accF[4], accB[4];
#pragma unroll
        for (int pt = 0; pt < 4; ++pt) { accY[pt] = (f32x4){0.f, 0.f, 0.f, 0.f}; accF[pt] = accY[pt]; accB[pt] = accY[pt]; }
        const LAS unsigned char* Sx = SB + (hs * 3 + 0) * P5_MAT; const LAS unsigned char* Sf = SB + (hs * 3 + 1) * P5_MAT; const LAS unsigned char* Sb = SB + (hs * 3 + 2) * P5_MAT;
#pragma unroll
        for (int kk = 0; kk < 4; ++kk)
#pragma unroll
            for (int pt = 0; pt < 4; ++pt) { const int ro = (pt * 16 + fr) * P5_PITCH;
                const v2u lo = *(const LAS v2u*)(Sx + ro + ((2 * kk) * 16 + fq * 4) * 2), hi = *(const LAS v2u*)(Sx + ro + ((2 * kk + 1) * 16 + fq * 4) * 2);
                const bf16x8 Xf = __builtin_bit_cast(bf16x8, ((v4u){lo.x, lo.y, hi.x, hi.y}));
                accY[pt] = __builtin_amdgcn_mfma_f32_16x16x32_bf16(Xf, Mf[kk], accY[pt], 0, 0, 0);
                const bf16x8 Hf = *(const LAS bf16x8*)(Sf + ro + (kk * 32 + fq * 8) * 2);
                accF[pt] = __builtin_amdgcn_mfma_f32_16x16x32_bf16(Hf, Cf[kk], accF[pt], 0, 0, 0);
                const bf16x8 Hb = *(const LAS bf16x8*)(Sb + ro + (kk * 32 + fq * 8) * 2);
                accB[pt] = __builtin_amdgcn_mfma_f32_16x16x32_bf16(Hb, Cf[kk], accB[pt], 0, 0, 0); }
        const float ef = __expf(alf), eb = __expf(alb);
#pragma unroll
        for (int pt = 0; pt < 4; ++pt) {
            const v2u zr = *(const v2u*)(proj + (size_t)(t0 + lrow) * NPROJ + h * 64 + pt * 16 + fq * 4);
            const float z[4] = {bflo(zr.x), bfhi(zr.x), bflo(zr.y), bfhi(zr.y)}; float y[4];
#pragma unroll
            for (int r = 0; r < 4; ++r) { y[r] = (accY[pt][r] + ef * accF[pt][r] + eb * accB[pt][r]) * (z[r] / (1.f + __expf(-z[r]))); sumsq += y[r] * y[r]; }
            *(v2u*)(yrow + i * 64 + pt * 16) = (v2u){pk2(y[0], y[1]), pk2(y[2], y[3])}; }
        __syncthreads();
    }
    sumsq += __shfl_xor(sumsq, 16); sumsq += __shfl_xor(sumsq, 32);
    if (fq == 0) Q[hs * 64 + rt * 16 + fr] = sumsq;
    __syncthreads();
    const float rs = 1.f / sqrtf((Q[rt * 16 + fr] + Q[64 + rt * 16 + fr]) * (1.f / 512.f) + EPS);
#pragma unroll
    for (int i = 0; i < 4; ++i)
#pragma unroll
        for (int pt = 0; pt < 4; ++pt) { bf16* yp = yrow + i * 64 + pt * 16; const v2u yv = *(const v2u*)yp; const int ch = g * 512 + (hs * 4 + i) * 64 + pt * 16 + fq * 4; const f32x4 nw = *(const f32x4*)(P.ssd_norm + ch);
            *(v2u*)yp = (v2u){pk2(bflo(yv.x) * rs * nw.x, bfhi(yv.x) * rs * nw.y), pk2(bflo(yv.y) * rs * nw.z, bfhi(yv.y) * rs * nw.w)}; }
#undef P5_LOAD
#undef P5_STORE
}

__device__ __forceinline__ void res_norm_norm_row(const float* m, const float* hin, float* hout, const float* g1, const float* g2, bf16* hn, int lane) {
    f32x4 v[8]; float s = 0.f;
#pragma unroll
    for (int j = 0; j < 8; ++j) { v[j] = ((const f32x4*)m)[lane + 64 * j]; s += dot4(v[j]); }
    const float r1 = 1.f / sqrtf(wave_sum(s) * (1.f / DM) + EPS); float s2 = 0.f;
#pragma unroll
    for (int j = 0; j < 8; ++j) { const f32x4 gv = ((const f32x4*)g1)[lane + 64 * j], hv = ((const f32x4*)hin)[lane + 64 * j]; v[j] = hv + v[j] * r1 * gv; s2 += dot4(v[j]); ((f32x4*)hout)[lane + 64 * j] = v[j]; }
    const float r2 = 1.f / sqrtf(wave_sum(s2) * (1.f / DM) + EPS);
#pragma unroll
    for (int j = 0; j < 8; ++j) { const f32x4 gv = ((const f32x4*)g2)[lane + 64 * j]; const f32x4 o = v[j] * r2 * gv; *(v2u*)(hn + (size_t)(lane + 64 * j) * 4) = (v2u){pk2(o.x, o.y), pk2(o.z, o.w)}; }
}
__device__ __forceinline__ void res_norm_row(const float* m, const float* hin, float* hout, const float* g1, int lane) {
    f32x4 v[8]; float s = 0.f;
#pragma unroll
    for (int j = 0; j < 8; ++j) { v[j] = ((const f32x4*)m)[lane + 64 * j]; s += dot4(v[j]); }
    const float r1 = 1.f / sqrtf(wave_sum(s) * (1.f / DM) + EPS);
#pragma unroll
    for (int j = 0; j < 8; ++j) { const f32x4 gv = ((const f32x4*)g1)[lane + 64 * j], hv = ((const f32x4*)hin)[lane + 64 * j]; ((f32x4*)hout)[lane + 64 * j] = hv + v[j] * r1 * gv; }
}

__device__ __forceinline__ float gelu_tanh(float x) { const float u = 0.7978845608028654f * (x + 0.044715f * x * x * x); const float t = 1.f - 2.f / (1.f + __expf(2.f * u)); return 0.5f * x * (1.f + t); }
__device__ __forceinline__ void p9_phase(const Ptrs& P, int G, int wave, int lane) {
    const int gw = blockIdx.x * NWAVES + wave, NGW = G * NWAVES;
    bf16* up = (bf16*)(P.ws + WS_UP);
    for (int it = gw; it < 1024 * 11; it += NGW) {
        const int tb = it / 11, cb = it % 11, t0 = tb * 8, ch = cb * 512 + lane * 8;
        float w0[8], w1[8], w2[8], bb[8];
#pragma unroll
        for (int q = 0; q < 2; ++q) { const f32x4 a = *(const f32x4*)(P.ffn_conv_w + ch + 4 * q), b = *(const f32x4*)(P.ffn_conv_w + DFF + ch + 4 * q), c = *(const f32x4*)(P.ffn_conv_w + 2 * DFF + ch + 4 * q), d = *(const f32x4*)(P.ffn_conv_b + ch + 4 * q);
#pragma unroll
            for (int e = 0; e < 4; ++e) { w0[4 * q + e] = a[e]; w1[4 * q + e] = b[e]; w2[4 * q + e] = c[e]; bb[4 * q + e] = d[e]; } }
        v4u prev, cur, nxt;
        prev = (t0 > 0) ? *(const v4u*)(up + (size_t)(t0 - 1) * (2 * DFF) + ch) : (v4u){0u, 0u, 0u, 0u};
        cur = *(const v4u*)(up + (size_t)t0 * (2 * DFF) + ch);
#pragma unroll
        for (int i = 0; i < 8; ++i) { const int t = t0 + i;
            nxt = (t + 1 < L) ? *(const v4u*)(up + (size_t)(t + 1) * (2 * DFF) + ch) : (v4u){0u, 0u, 0u, 0u};
            const v4u vv = *(const v4u*)(up + (size_t)t * (2 * DFF) + DFF + ch);
            const unsigned pw[4] = {prev.x, prev.y, prev.z, prev.w}, cw[4] = {cur.x, cur.y, cur.z, cur.w}, nw[4] = {nxt.x, nxt.y, nxt.z, nxt.w}, vw[4] = {vv.x, vv.y, vv.z, vv.w}; unsigned ow[4];
#pragma unroll
            for (int q = 0; q < 4; ++q) {
                const float g0 = bb[2 * q] + w0[2 * q] * bflo(pw[q]) + w1[2 * q] * bflo(cw[q]) + w2[2 * q] * bflo(nw[q]);
                const float g1 = bb[2 * q + 1] + w0[2 * q + 1] * bfhi(pw[q]) + w1[2 * q + 1] * bfhi(cw[q]) + w2[2 * q + 1] * bfhi(nw[q]);
                ow[q] = pk2(gelu_tanh(g0) * bflo(vw[q]), gelu_tanh(g1) * bfhi(vw[q])); }
            *(v4u*)(up + (size_t)t * (2 * DFF) + DFF + ch) = (v4u){ow[0], ow[1], ow[2], ow[3]};
            prev = cur; cur = nxt; }
    }
}

struct Args { Ptrs P; int ph_lo, ph_hi, coop, pad; };
__global__ void __launch_bounds__(NWAVES * 64, 2) fwd_kernel(Args args) {
    extern __shared__ __attribute__((aligned(16))) unsigned char lds_raw[];
    LAS unsigned char* lds = (LAS unsigned char*)lds_raw;
    const Ptrs& P = args.P;
    const int G = gridDim.x;
#define PH_VARS int tid_ = threadIdx.x; asm volatile("" : "+v"(tid_)); const int tid = tid_, lane = tid & 63, wave = __builtin_amdgcn_readfirstlane(tid >> 6), gw = blockIdx.x * NWAVES + wave, NGW = G * NWAVES; (void)tid; (void)lane; (void)gw; (void)NGW;
    const int lo = args.ph_lo, hi = args.ph_hi;
#define IN(k) (lo <= (k) && (k) < hi)
    volatile LAS unsigned* MISC = (volatile LAS unsigned*)(lds + LDS_MISC);
    if (threadIdx.x < 32) MISC[threadIdx.x] = 0u;
    __syncthreads();
    XcdBarrier bar; bar.bar = (unsigned*)P.ws + CW_BAR; bar.x = 0; bar.st = nullptr;
    if (args.coop) bar = xcd_barrier_post((unsigned*)P.ws + CW_BAR, MISC + 8);
    if (args.coop == 2) cg::this_grid().sync();
#define SEAM(k) do { if (IN(k) && IN((k) + 1)) { xcd_barrier(bar); } } while (0)
    unsigned char* ws = P.ws;
#define HN ((bf16*)(ws + WS_HN))

    if (IN(0)) { PH_VARS p0_prologue(P, lds, G, wave, lane); } SEAM(0);
    if (IN(1)) {
        pg8::Gemm g{HN, (const bf16*)(ws + WS_WIN), DM, DM, DM, 0}; pg8::StaticOrder S; S.init(L, NPROJ_PAD, G, (int)blockIdx.x);
        pg8::EpiProj E{(bf16*)(ws + WS_PROJ), (float*)(ws + WS_DTRAW)};
        pg8::gemm_phase<pg8::EpiProj, pg8::StaticOrder, true, true>(lds, g, S, E);
    } SEAM(1);
    if (IN(2)) { PH_VARS p2_phase(P, G, wave, lane); } SEAM(2);
    if (IN(3)) { PH_VARS p3_phase(P, G, wave, lane); } SEAM(3);
    if (IN(4)) { p4_phase(P, G); } SEAM(4);
    if (IN(5)) { PH_VARS
        for (int u = blockIdx.x; u < NCH * 4; u += G) p5_ssd_unit(P, lds, u >> 2, (u >> 1) & 1, u & 1, tid, wave, lane);
        __syncthreads();
        int k256 = 256; asm volatile("" : "+s"(k256));
        {
            pg8::Gemm g{(const bf16*)(ws + WS_MIXED), (const bf16*)(ws + WS_WPOOL), 1024, 256, k256, 256}; pg8::StaticOrder S; S.init(L, 1024, G, (int)blockIdx.x);
            pg8::EpiBf16 E{(bf16*)(ws + WS_YCAT) + 1024, DM};
            pg8::gemm_phase<pg8::EpiBf16, pg8::StaticOrder, true, true>(lds, g, S, E);
        }
        {
            pg8::Gemm g{(const bf16*)(ws + WS_PBF), (const bf16*)(ws + WS_WPLE), DPLE, DPLE, k256, 0}; pg8::StaticOrder S; S.init(L, DM, G, (int)blockIdx.x);
            pg8::EpiBf16 E{(bf16*)(ws + WS_PP), DM};
            pg8::gemm_phase<pg8::EpiBf16, pg8::StaticOrder, true, true>(lds, g, S, E);
        }
    } SEAM(5);
    if (IN(6)) {
        pg8::Gemm g{(const bf16*)(ws + WS_YCAT), (const bf16*)(ws + WS_WOUT), DM, DM, DM, 0}; pg8::StaticOrder S; S.init(L, DM, G, (int)blockIdx.x);
        pg8::EpiF32 E{(float*)(ws + WS_MIX), DM};
        pg8::gemm_phase<pg8::EpiF32, pg8::StaticOrder, true, true>(lds, g, S, E);
    } SEAM(6);
    if (IN(7)) { PH_VARS
        for (int m = gw; m < L; m += NGW) res_norm_norm_row((const float*)(ws + WS_MIX) + (size_t)m * DM, P.x + (size_t)m * DM, P.out + (size_t)m * DM, P.mix_norm_post, P.ffn_norm_pre, HN + (size_t)m * DM, lane);
    } SEAM(7);
    if (IN(8)) {
        pg8::Gemm g{HN, (const bf16*)(ws + WS_WUP), DM, DM, DM, 0}; pg8::StaticOrder S; S.init(L, 2 * DFF, G, (int)blockIdx.x);
        pg8::EpiGlu E{(bf16*)(ws + WS_ACT), (float*)(ws + WS_EDGE), P.ffn_conv_w, P.ffn_conv_b, lds + LDS_XCH};
        pg8::gemm_phase<pg8::EpiGlu, pg8::StaticOrder, true, true>(lds, g, S, E);
    } SEAM(8);
    if (IN(10)) { PH_VARS
        pg8::Gemm g{(const bf16*)(ws + WS_ACT), (const bf16*)(ws + WS_WDOWN), DFF, DFF, DFF, 0}; pg8::StaticOrder S; S.init(L, DM, G, (int)blockIdx.x);
        { pg8::Unit u0; if (S.next(0, u0)) { const int pm = u0.pm; const float* E = (const float*)(ws + WS_EDGE); bf16* act = (bf16*)(ws + WS_ACT); const float* Ec = E + (size_t)pm * 6 * DFF;
            for (int idx = tid; idx < 2 * DFF; idx += NWAVES * 64) { const int which = idx >= DFF, ch = idx - which * DFF; float prev, cur, next, val; int row;
                if (!which) { prev = pm > 0 ? E[((size_t)(pm - 1) * 6 + 3) * DFF + ch] : 0.f; cur = Ec[0 * DFF + ch]; next = Ec[1 * DFF + ch]; val = Ec[4 * DFF + ch]; row = 256 * pm; }
                else { prev = Ec[2 * DFF + ch]; cur = Ec[3 * DFF + ch]; next = pm < 31 ? E[((size_t)(pm + 1) * 6 + 0) * DFF + ch] : 0.f; val = Ec[5 * DFF + ch]; row = 256 * pm + 255; }
                const float a = P.ffn_conv_b[ch] + P.ffn_conv_w[ch] * prev + P.ffn_conv_w[DFF + ch] * cur + P.ffn_conv_w[2 * DFF + ch] * next;
                act[(size_t)row * DFF + ch] = (bf16)f2bf(pg8::gelu_tanh_f(a) * val); } }
          __builtin_amdgcn_fence(__ATOMIC_SEQ_CST, "agent"); __syncthreads(); }
        pg8::EpiF32 E{(float*)(ws + WS_FF), DM};
        pg8::gemm_phase<pg8::EpiF32, pg8::StaticOrder, true, true>(lds, g, S, E);
    } SEAM(10);
    if (IN(11)) { PH_VARS
        bf16* hn3 = (bf16*)(ws + WS_HN3);
        for (int m = gw; m < L; m += NGW) res_norm_norm_row((const float*)(ws + WS_FF) + (size_t)m * DM, P.out + (size_t)m * DM, P.out + (size_t)m * DM, P.ffn_norm_post, P.ple_norm_pre, hn3 + (size_t)m * DM, lane);
    } SEAM(11);
    if (IN(12)) {
        pg8::Gemm g{(const bf16*)(ws + WS_HN3), (const bf16*)(ws + WS_WGATE), DM, DM, DM, 0}; pg8::StaticOrder S; S.init(L, DM, G, (int)blockIdx.x);
        pg8::EpiGate E{(float*)(ws + WS_T), (const bf16*)(ws + WS_PP), DM};
        pg8::gemm_phase<pg8::EpiGate, pg8::StaticOrder, true, true>(lds, g, S, E);
    } SEAM(12);
    if (IN(13)) { PH_VARS
        for (int m = gw; m < L; m += NGW) res_norm_row((const float*)(ws + WS_T) + (size_t)m * DM, P.out + (size_t)m * DM, P.out + (size_t)m * DM, P.ple_norm_post, lane);
    }
#undef IN
#undef SEAM
}

extern "C" void kernel_launch(void* const* d_in, const int* in_sizes, int n_in, void* d_out, int out_size, void* d_ws, size_t ws_size, hipStream_t stream) {
    static int grid = 0;
    if (grid == 0) {
        if (n_in != 24 || in_sizes[0] != L * DM || out_size != L * DM || ws_size < WS_END) { fprintf(stderr, "kernel_launch: unexpected shapes / workspace (n_in %d, ws %zu, need %zu)\n", n_in, ws_size, (size_t)WS_END); grid = -1; return; }
        int dev = 0, cus = 0, per_cu = 0;
        hipGetDevice(&dev); hipDeviceGetAttribute(&cus, hipDeviceAttributeMultiprocessorCount, dev);
        if (hipFuncSetAttribute((const void*)fwd_kernel, hipFuncAttributeMaxDynamicSharedMemorySize, LDS_BYTES) != hipSuccess) { fprintf(stderr, "kernel_launch: hipFuncSetAttribute failed\n"); grid = -1; return; }
        if (hipOccupancyMaxActiveBlocksPerMultiprocessor(&per_cu, (const void*)fwd_kernel, NWAVES * 64, LDS_BYTES) != hipSuccess || per_cu < 1) { fprintf(stderr, "kernel_launch: occupancy query says %d\n", per_cu); per_cu = 1; }
        (void)hipGetLastError();
        grid = cus * 1;
    }
    if (grid < 0) return;
    Args a{};
    const float** pp = (const float**)&a.P;
    for (int i = 0; i < 24; ++i) pp[i] = (const float*)d_in[i];
    a.P.out = (float*)d_out; a.P.ws = (unsigned char*)d_ws;
#if MK_N_LAUNCHES == 1
    if (hipMemsetAsync(d_ws, 0, CTL_ZERO_BYTES, stream) != hipSuccess) { fprintf(stderr, "kernel_launch: memset of the barrier words failed\n"); return; }
    a.ph_lo = 0; a.ph_hi = N_PHASES; a.coop = 1;
    void* kargs[] = {&a};
    hipError_t e = hipLaunchCooperativeKernel((const void*)fwd_kernel, dim3(grid), dim3(NWAVES * 64), kargs, LDS_BYTES, stream);
    if (e != hipSuccess) fprintf(stderr, "cooperative launch failed: %s (grid %d)\n", hipGetErrorString(e), grid);
#else
    for (int li = 0; li < N_PHASES; ++li) { a.ph_lo = li; a.ph_hi = li + 1; a.coop = 0;
        for (int rep = 0; rep < 1 + (int)((DUP_MASK >> li) & 1u); ++rep) hipLaunchKernelGGL(fwd_kernel, dim3(grid), dim3(NWAVES * 64), LDS_BYTES, stream, a); }
#endif
}
```

```cpp
#include <hip/hip_runtime.h>
#include <hip/hip_cooperative_groups.h>
#include <cstdio>
#include <cstdint>
namespace cg = cooperative_groups;

namespace pg8 {
#define PG8_LAS __attribute__((address_space(3)))
typedef unsigned short bf16_t;
typedef short bf16x8 __attribute__((ext_vector_type(8)));
typedef float f32x4 __attribute__((ext_vector_type(4)));
typedef unsigned u32x4 __attribute__((ext_vector_type(4)));
typedef unsigned u32x2 __attribute__((ext_vector_type(2)));
constexpr int BM = 256, BK = 64, HALF = 128, HTB = HALF * BK * 2  , STAGE_BYTES = 8 * HTB, NXCD = 8, WGM = 8;

__host__ __device__ __forceinline__ int lds_byte(int r, int c) { const int st = (r >> 4) * 2 + (c >> 5), rr = r & 15, cc = c & 31, ob = rr * 64 + cc * 2; return st * 1024 + (ob ^ (((ob >> 9) & 1) << 5)); }
__host__ __device__ __forceinline__ void stage_rc(int b, int& R, int& C) { const int st = b / 1024, sb = b % 1024, swz = sb ^ (((sb >> 9) & 1) << 5); R = (st >> 1) * 16 + swz / 64; C = (st & 1) * 32 + (swz % 64) / 2; }
__host__ __device__ __forceinline__ int perm32(int rho) { const int n = rho >> 4, i = rho & 15; return 8 * (i >> 2) + 4 * n + (i & 3); }

struct Unit { int pm, pn; };
struct Gemm { const bf16_t* A; const bf16_t* Bt; int lda, ldb, K, a_pn_off;
    __device__ __forceinline__ const char* a_ptr(const Unit& u) const { return (const char*)(A + (size_t)u.pm * BM * lda + (size_t)u.pn * a_pn_off); }
    __device__ __forceinline__ const char* b_ptr(const Unit& u) const { return (const char*)(Bt + (size_t)u.pn * BM * ldb); }
};

struct StaticOrder {
    int nM, nN, nwg, G, c;
    __host__ __device__ void init(int M, int N, int G_, int c_) { nM = M / BM; nN = N / BM; nwg = nM * nN; G = G_; c = c_; }
    __host__ __device__ bool next(int i, Unit& u) const {
        const long L = (long)i * G + c; if (L >= nwg) return false;
        int wgid = (int)L; { const int q = nwg / NXCD, r = nwg % NXCD, xcd = wgid % NXCD, off = wgid / NXCD; wgid = (xcd < r ? xcd * (q + 1) : r * (q + 1) + (xcd - r) * q) + off; }
        const int nig = WGM * nN, gid = wgid / nig, fm = gid * WGM, gsz = (nM - fm) < WGM ? (nM - fm) : WGM;
        u.pm = fm + ((wgid % nig) % gsz); u.pn = (wgid % nig) / gsz; return true;
    }
    __device__ __forceinline__ void a_ready(const Unit&) const {}
    __device__ __forceinline__ void done(const Unit&) const {}
};

__device__ __forceinline__ unsigned cvt_pk_bf16(float lo, float hi) { unsigned r; asm volatile("v_cvt_pk_bf16_f32 %0, %1, %2" : "=v"(r) : "v"(lo), "v"(hi)); return r; }

struct EpiBf16 {
    static constexpr bool PERM = true, AFTER_DRAIN = false;
    bf16_t* O; int ldc;
    __device__ __forceinline__ void operator()(const f32x4 (&acc)[2][2][4][2], const Unit& u, int wr, int wc, int fr, int fq) const {
        const int row0 = u.pm * BM + wr * 64 + fr; const int col0 = u.pn * BM + wc * 32 + 8 * fq;
#pragma unroll
        for (int ai = 0; ai < 2; ++ai)
#pragma unroll
            for (int m = 0; m < 4; ++m) { bf16_t* rowp = O + (size_t)(row0 + ai * HALF + m * 16) * ldc + col0;
#pragma unroll
                for (int bj = 0; bj < 2; ++bj) { const f32x4 v0 = acc[ai][bj][m][0], v1 = acc[ai][bj][m][1];
                    u32x4 w; w.x = cvt_pk_bf16(v0[0], v0[1]); w.y = cvt_pk_bf16(v0[2], v0[3]); w.z = cvt_pk_bf16(v1[0], v1[1]); w.w = cvt_pk_bf16(v1[2], v1[3]);
                    *(u32x4*)(rowp + bj * HALF) = w; } }
    }
};
struct EpiProj {
    static constexpr bool PERM = true, AFTER_DRAIN = false;
    bf16_t* O; float* dtraw;
    __device__ __forceinline__ void operator()(const f32x4 (&acc)[2][2][4][2], const Unit& u, int wr, int wc, int fr, int fq) const {
        const int row0 = u.pm * BM + wr * 64 + fr;
        if (u.pn < 14) { const int col0 = u.pn * BM + wc * 32 + 8 * fq;
#pragma unroll
            for (int ai = 0; ai < 2; ++ai)
#pragma unroll
                for (int m = 0; m < 4; ++m) { bf16_t* rowp = O + (size_t)(row0 + ai * HALF + m * 16) * 3584 + col0;
#pragma unroll
                    for (int bj = 0; bj < 2; ++bj) { const f32x4 v0 = acc[ai][bj][m][0], v1 = acc[ai][bj][m][1];
                        u32x4 w; w.x = cvt_pk_bf16(v0[0], v0[1]); w.y = cvt_pk_bf16(v0[2], v0[3]); w.z = cvt_pk_bf16(v1[0], v1[1]); w.w = cvt_pk_bf16(v1[2], v1[3]);
                        *(u32x4*)(rowp + bj * HALF) = w; } }
        } else if (wc == 0) {
#pragma unroll
            for (int ai = 0; ai < 2; ++ai)
#pragma unroll
                for (int m = 0; m < 4; ++m) { float* rp = dtraw + (size_t)(row0 + ai * HALF + m * 16) * 32 + 8 * fq;
                    *(f32x4*)rp = acc[ai][0][m][0]; *(f32x4*)(rp + 4) = acc[ai][0][m][1]; }
        }
    }
};

__device__ __forceinline__ float dpp_ror1(float x) { return __builtin_bit_cast(float, __builtin_amdgcn_update_dpp(0, __builtin_bit_cast(int, x), 0x121, 0xf, 0xf, false)); }
__device__ __forceinline__ float dpp_ror15(float x) { return __builtin_bit_cast(float, __builtin_amdgcn_update_dpp(0, __builtin_bit_cast(int, x), 0x12f, 0xf, 0xf, false)); }
__device__ __forceinline__ float gelu_tanh_f(float x) { const float u = 0.7978845608028654f * (x + 0.044715f * x * x * x); const float t = 1.f - 2.f / (1.f + __expf(2.f * u)); return 0.5f * x * (1.f + t); }
struct EpiGlu {
    static constexpr bool PERM = true, AFTER_DRAIN = false;
    bf16_t* act; float* E; const float* cw; const float* cbias; PG8_LAS unsigned char* xl;
    __device__ __forceinline__ void operator()(const f32x4 (&acc)[2][2][4][2], const Unit& u, int wr, int wc, int fr, int fq) const {
        const int cl = wc * 32 + 8 * fq, ch = u.pn * 128 + cl;
        PG8_LAS float* X = (PG8_LAS float*)xl;
#pragma unroll
        for (int ai = 0; ai < 2; ++ai) { const int rb = ai * 2 + wr;
#pragma unroll
            for (int n = 0; n < 2; ++n) { const f32x4 top = acc[ai][0][0][n], bot = acc[ai][0][3][n]; f32x4 sel;
                sel[0] = fr == 0 ? top[0] : bot[0]; sel[1] = fr == 0 ? top[1] : bot[1]; sel[2] = fr == 0 ? top[2] : bot[2]; sel[3] = fr == 0 ? top[3] : bot[3];
                if (fr == 0 || fr == 15) *(PG8_LAS f32x4*)(X + (rb * 2 + (fr == 15 ? 1 : 0)) * 128 + cl + 4 * n) = sel; } }
        float* Ep = E + (size_t)u.pm * 6 * 5632 + ch;
#pragma unroll
        for (int n = 0; n < 2; ++n) { const f32x4 g0 = acc[0][0][0][n], g1 = acc[1][0][3][n], v0 = acc[0][1][0][n], v1 = acc[1][1][3][n]; f32x4 gs, vs;
#pragma unroll
            for (int j = 0; j < 4; ++j) { gs[j] = wr ? g1[j] : g0[j]; vs[j] = wr ? v1[j] : v0[j]; }
            const bool gc = wr ? (fr >= 14) : (fr < 2); const int gi = wr ? fr - 12 : fr;
            if (gc) *(f32x4*)(Ep + (size_t)gi * 5632 + 4 * n) = gs;
            if (wr ? (fr == 15) : (fr == 0)) *(f32x4*)(Ep + (size_t)(4 + wr) * 5632 + 4 * n) = vs; }
        asm volatile("s_waitcnt lgkmcnt(0)" ::: "memory"); __builtin_amdgcn_s_barrier(); asm volatile("" ::: "memory");
#pragma unroll
        for (int n = 0; n < 2; ++n) {
            const f32x4 w0 = *(const f32x4*)(cw + ch + 4 * n), w1 = *(const f32x4*)(cw + 5632 + ch + 4 * n), w2 = *(const f32x4*)(cw + 2 * 5632 + ch + 4 * n), bb = *(const f32x4*)(cbias + ch + 4 * n);
#pragma unroll
            for (int ai = 0; ai < 2; ++ai) { const int rb = ai * 2 + wr;
                const f32x4 xp = rb > 0 ? *(const PG8_LAS f32x4*)(X + ((rb - 1) * 2 + 1) * 128 + cl + 4 * n) : (f32x4){0.f, 0.f, 0.f, 0.f};
                const f32x4 xn = rb < 3 ? *(const PG8_LAS f32x4*)(X + ((rb + 1) * 2 + 0) * 128 + cl + 4 * n) : (f32x4){0.f, 0.f, 0.f, 0.f};
#pragma unroll
                for (int m = 0; m < 4; ++m) { float o[4]; const f32x4 g = acc[ai][0][m][n], v = acc[ai][1][m][n];
#pragma unroll
                    for (int j = 0; j < 4; ++j) {
                        const float up1 = dpp_ror1(g[j]), dn1 = dpp_ror15(g[j]);
                        const float pmv = (m > 0) ? dpp_ror1(acc[ai][0][m > 0 ? m - 1 : 0][n][j]) : xp[j];
                        const float nmv = (m < 3) ? dpp_ror15(acc[ai][0][m < 3 ? m + 1 : 3][n][j]) : xn[j];
                        const float prev = fr ? up1 : pmv, next = (fr < 15) ? dn1 : nmv;
                        const float a = bb[j] + w0[j] * prev + w1[j] * g[j] + w2[j] * next;
                        o[j] = gelu_tanh_f(a) * v[j]; }
                    u32x2 w; w.x = cvt_pk_bf16(o[0], o[1]); w.y = cvt_pk_bf16(o[2], o[3]);
                    *(u32x2*)(act + (size_t)(u.pm * BM + ai * HALF + wr * 64 + m * 16 + fr) * 5632 + ch + 4 * n) = w; }
                asm volatile("" ::: "memory"); } }
    }
};
struct EpiF32 {
    static constexpr bool PERM = false, AFTER_DRAIN = false;
    float* out; int ldc;
    __device__ __forceinline__ void operator()(const f32x4 (&acc)[2][2][4][2], const Unit& u, int wr, int wc, int fr, int fq) const {
        const int col0 = u.pn * BM + wc * 32 + 4 * fq;
#pragma unroll
        for (int ai = 0; ai < 2; ++ai)
#pragma unroll
            for (int m = 0; m < 4; ++m) { const size_t off = (size_t)(u.pm * BM + ai * HALF + wr * 64 + m * 16 + fr) * ldc + col0;
#pragma unroll
                for (int bj = 0; bj < 2; ++bj)
#pragma unroll
                    for (int n = 0; n < 2; ++n) *(f32x4*)(out + off + bj * HALF + n * 16) = acc[ai][bj][m][n]; }
    }
};
struct EpiGate {
    static constexpr bool PERM = false, AFTER_DRAIN = false;
    float* out; const bf16_t* pp; int ldc;
    __device__ __forceinline__ void operator()(const f32x4 (&acc)[2][2][4][2], const Unit& u, int wr, int wc, int fr, int fq) const {
        const int col0 = u.pn * BM + wc * 32 + 4 * fq;
#pragma unroll
        for (int ai = 0; ai < 2; ++ai)
#pragma unroll
            for (int m = 0; m < 4; ++m) { const size_t off = (size_t)(u.pm * BM + ai * HALF + wr * 64 + m * 16 + fr) * ldc + col0;
#pragma unroll
                for (int bj = 0; bj < 2; ++bj)
#pragma unroll
                    for (int n = 0; n < 2; ++n) { const u32x2 pv = *(const u32x2*)(pp + off + bj * HALF + n * 16); const f32x4 a = acc[ai][bj][m][n]; f32x4 o;
                        o[0] = __uint_as_float(pv.x << 16) / (1.f + __expf(-a[0])); o[1] = __uint_as_float(pv.x & 0xffff0000u) / (1.f + __expf(-a[1]));
                        o[2] = __uint_as_float(pv.y << 16) / (1.f + __expf(-a[2])); o[3] = __uint_as_float(pv.y & 0xffff0000u) / (1.f + __expf(-a[3]));
                        *(f32x4*)(out + off + bj * HALF + n * 16) = o; } }
    }
};

template <class Epi, class Sched, bool ALIGN_EPI = false, bool SP2 = false>
__device__ __forceinline__ void gemm_phase(PG8_LAS unsigned char* lds, const Gemm g, const Sched& S, const Epi& E) {
    int tid_ = threadIdx.x; asm volatile("" : "+v"(tid_));
    const int tid = tid_, wid = __builtin_amdgcn_readfirstlane(tid >> 6), lane = tid & 63, wr = wid >> 2, wc = wid & 3, fr = lane & 15, fq = lane >> 4;
    const int K = g.K, nt = K / BK;
    unsigned voffA[2], voffB[2];
#pragma unroll
    for (int i = 0; i < 2; ++i) { int R, C; stage_rc(tid * 16 + i * 8192, R, C); const int Rb = Epi::PERM ? ((R & ~31) + perm32(R & 31)) : R;
        voffA[i] = (unsigned)(R * g.lda + C) * 2u; voffB[i] = (unsigned)(Rb * g.ldb + C) * 2u; }
    const size_t kstep = (size_t)(BK * 2);
    const size_t hstepA = (size_t)HALF * g.lda * 2, hstepB = (size_t)HALF * g.ldb * 2;
    const unsigned ldsw = (unsigned)wid * 1024u;
    const int aoff = lds_byte(wr * 64 + fr, fq * 8), boff = lds_byte(wc * 32 + fr, fq * 8);
#define PG8_SA(b, h) (((b) * 2 + (h)) * HTB)
#define PG8_SB(b, h) ((4 + (b) * 2 + (h)) * HTB)
#define PG8_STAGE(bufoff, gbase, voff) do { _Pragma("unroll") for (int _i = 0; _i < 2; ++_i) \
        __builtin_amdgcn_global_load_lds((const unsigned*)((const char*)(gbase) + (voff)[_i]), (PG8_LAS unsigned*)(lds + (bufoff) + ldsw + _i * 8192), 16, 0, 0); } while (0)
#define PG8_LDA(dst, b, h) do { _Pragma("unroll") for (int m = 0; m < 4; ++m) _Pragma("unroll") for (int k = 0; k < 2; ++k) dst[m][k] = *(const PG8_LAS bf16x8*)(lds + PG8_SA(b, h) + aoff + m * 2048 + k * 1024); } while (0)
#define PG8_LDB(dst, b, h) do { _Pragma("unroll") for (int n = 0; n < 2; ++n) _Pragma("unroll") for (int k = 0; k < 2; ++k) dst[n][k] = *(const PG8_LAS bf16x8*)(lds + PG8_SB(b, h) + boff + n * 2048 + k * 1024); } while (0)
#define PG8_MMA(ai, bj, At, Bt) do { __builtin_amdgcn_s_setprio(1); _Pragma("unroll") for (int m = 0; m < 4; ++m) _Pragma("unroll") for (int n = 0; n < 2; ++n) _Pragma("unroll") for (int k = 0; k < 2; ++k) \
        acc[ai][bj][m][n] = __builtin_amdgcn_mfma_f32_16x16x32_bf16(Bt[n][k], At[m][k], acc[ai][bj][m][n], 0, 0, 0); __builtin_amdgcn_s_setprio(0); } while (0)
#define PG8_WAIT_V(n) asm volatile("s_waitcnt vmcnt(" #n ")" ::: "memory")
#define PG8_WAIT_L(n) asm volatile("s_waitcnt lgkmcnt(" #n ")" ::: "memory")
#define PG8_BAR __builtin_amdgcn_s_barrier()
#define PG8_SCHED __builtin_amdgcn_sched_barrier(0)
    Unit cur, nxt; int ui = 0;
    if (!S.next(0, cur)) return;
    f32x4 acc[2][2][4][2];
#pragma unroll
    for (int a = 0; a < 2; ++a)
#pragma unroll
        for (int b = 0; b < 2; ++b)
#pragma unroll
            for (int m = 0; m < 4; ++m)
#pragma unroll
                for (int n = 0; n < 2; ++n) acc[a][b][m][n] = (f32x4){0.f, 0.f, 0.f, 0.f};
    bf16x8 At[4][2], B0[2][2], B1[2][2];
    const char* cA = g.a_ptr(cur); const char* cB = g.b_ptr(cur);
    S.a_ready(cur);
    if constexpr (SP2) {
        PG8_STAGE(PG8_SB(0, 0), cB, voffB); PG8_STAGE(PG8_SB(0, 1), cB + hstepB, voffB); PG8_STAGE(PG8_SA(0, 0), cA, voffA); PG8_STAGE(PG8_SA(0, 1), cA + hstepA, voffA);
        if (wr == 1) PG8_BAR;
        PG8_WAIT_V(2); PG8_BAR;
        PG8_STAGE(PG8_SB(1, 0), cB + kstep, voffB); PG8_STAGE(PG8_SA(1, 0), cA + kstep, voffA); PG8_STAGE(PG8_SB(1, 1), cB + hstepB + kstep, voffB);
        PG8_WAIT_V(6); PG8_BAR;
    } else {
        PG8_STAGE(PG8_SB(0, 0), cB, voffB); PG8_STAGE(PG8_SA(0, 0), cA, voffA); PG8_STAGE(PG8_SB(0, 1), cB + hstepB, voffB); PG8_STAGE(PG8_SA(0, 1), cA + hstepA, voffA);
        if (wr == 1) PG8_BAR;
        PG8_WAIT_V(4); PG8_BAR;
        PG8_STAGE(PG8_SB(1, 0), cB + kstep, voffB); PG8_STAGE(PG8_SA(1, 0), cA + kstep, voffA); PG8_STAGE(PG8_SB(1, 1), cB + hstepB + kstep, voffB);
        PG8_WAIT_V(6); PG8_BAR;
    }
    for (;;) {
        const bool has_next = S.next(ui + 1, nxt);
        const char* nA = has_next ? g.a_ptr(nxt) : cA; const char* nB = has_next ? g.b_ptr(nxt) : cB;
        for (int t = 0; t < nt; t += 2) {
            const bool last = (t == nt - 2);
            const char* a1 = cA + (size_t)(t + 1) * kstep;
            const char* a2 = last ? nA : cA + (size_t)(t + 2) * kstep; const char* b2 = last ? nB : cB + (size_t)(t + 2) * kstep;
            const char* a3 = a2 + kstep; const char* b3 = b2 + kstep;
            if (last && has_next) S.a_ready(nxt);
            if constexpr (SP2) {
            PG8_LDB(B0, 0, 0); PG8_LDB(B1, 0, 1); PG8_SCHED; PG8_LDA(At, 0, 0); PG8_STAGE(PG8_SA(1, 1), a1 + hstepA, voffA);
            PG8_WAIT_V(8); PG8_WAIT_L(0); PG8_BAR; PG8_MMA(0, 0, At, B0); PG8_MMA(0, 1, At, B1); PG8_BAR; PG8_SCHED;
            PG8_LDA(At, 0, 1); PG8_STAGE(PG8_SB(0, 0), b2, voffB); PG8_STAGE(PG8_SB(0, 1), b2 + hstepB, voffB); PG8_STAGE(PG8_SA(0, 0), a2, voffA);
            PG8_WAIT_V(8); PG8_WAIT_L(0); PG8_BAR; PG8_MMA(1, 0, At, B0); PG8_MMA(1, 1, At, B1); PG8_BAR; PG8_SCHED;
            PG8_LDB(B0, 1, 0); PG8_LDB(B1, 1, 1); PG8_SCHED; PG8_LDA(At, 1, 0); PG8_STAGE(PG8_SA(0, 1), a2 + hstepA, voffA);
            PG8_WAIT_V(8); PG8_WAIT_L(0); PG8_BAR; PG8_MMA(0, 0, At, B0); PG8_MMA(0, 1, At, B1); PG8_BAR; PG8_SCHED;
            PG8_LDA(At, 1, 1); PG8_STAGE(PG8_SB(1, 0), b3, voffB); PG8_STAGE(PG8_SB(1, 1), b3 + hstepB, voffB); PG8_STAGE(PG8_SA(1, 0), a3, voffA);
            PG8_WAIT_V(8); PG8_WAIT_L(0); PG8_BAR; PG8_MMA(1, 0, At, B0); PG8_MMA(1, 1, At, B1); PG8_BAR; PG8_SCHED;
            } else {
            PG8_LDB(B0, 0, 0); PG8_SCHED; PG8_LDA(At, 0, 0); PG8_STAGE(PG8_SA(1, 1), a1 + hstepA, voffA);
            PG8_WAIT_L(8); PG8_BAR; PG8_WAIT_L(0); PG8_MMA(0, 0, At, B0); PG8_BAR; PG8_SCHED;
            PG8_LDB(B1, 0, 1); PG8_STAGE(PG8_SB(0, 0), b2, voffB);
            PG8_BAR; PG8_WAIT_L(0); PG8_MMA(0, 1, At, B1); PG8_BAR;
            PG8_LDA(At, 0, 1); PG8_STAGE(PG8_SA(0, 0), a2, voffA);
            PG8_BAR; PG8_WAIT_L(0); PG8_MMA(1, 0, At, B0); PG8_BAR; PG8_SCHED;
            PG8_STAGE(PG8_SB(0, 1), b2 + hstepB, voffB);
            PG8_WAIT_V(6); PG8_BAR; PG8_MMA(1, 1, At, B1); PG8_BAR;
            PG8_LDB(B0, 1, 0); PG8_SCHED; PG8_LDA(At, 1, 0); PG8_STAGE(PG8_SA(0, 1), a2 + hstepA, voffA);
            PG8_WAIT_L(8); PG8_BAR; PG8_WAIT_L(0); PG8_MMA(0, 0, At, B0); PG8_BAR; PG8_SCHED;
            PG8_LDB(B1, 1, 1); PG8_STAGE(PG8_SB(1, 0), b3, voffB);
            PG8_BAR; PG8_WAIT_L(0); PG8_MMA(0, 1, At, B1); PG8_BAR;
            PG8_LDA(At, 1, 1); PG8_STAGE(PG8_SA(1, 0), a3, voffA);
            PG8_BAR; PG8_WAIT_L(0); PG8_MMA(1, 0, At, B0); PG8_BAR; PG8_SCHED;
            PG8_STAGE(PG8_SB(1, 1), b3 + hstepB, voffB);
            PG8_WAIT_V(6); PG8_BAR; PG8_MMA(1, 1, At, B1); PG8_BAR;
            }
        }
        if constexpr (ALIGN_EPI) { if (wr == 0) PG8_BAR; }
        if constexpr (!Epi::AFTER_DRAIN) { E(acc, cur, wr, wc, fr, fq); S.done(cur); }
        if (!has_next) break;
#pragma unroll
        for (int a = 0; a < 2; ++a)
#pragma unroll
            for (int b = 0; b < 2; ++b)
#pragma unroll
                for (int m = 0; m < 4; ++m)
#pragma unroll
                    for (int n = 0; n < 2; ++n) acc[a][b][m][n] = (f32x4){0.f, 0.f, 0.f, 0.f};
        cur = nxt; cA = nA; cB = nB; ++ui;
        if constexpr (ALIGN_EPI) { if (wr == 1) PG8_BAR; }
    }
    PG8_WAIT_V(0);
    if constexpr (!ALIGN_EPI) { if (wr == 0) PG8_BAR; }
    PG8_BAR;
    if constexpr (Epi::AFTER_DRAIN) { E.fused(acc, cur, wr, wc, fr, fq, lds, wid, lane); S.done(cur); }
#undef PG8_SA
#undef PG8_SB
#undef PG8_STAGE
#undef PG8_LDA
#undef PG8_LDB
#undef PG8_MMA
#undef PG8_WAIT_V
#undef PG8_WAIT_L
#undef PG8_BAR
#undef PG8_SCHED
}
}

constexpr int NWAVES = 8;
constexpr int L = 8192, DM = 2048, DSSD = 1024, NH = 16, NCH = 64  , DFF = 5632, DPLE = 256;
constexpr int NPROJ = 3584;
constexpr int NPROJ_PAD = 3840;
constexpr float EPS = 1e-6f;
#ifndef MK_N_LAUNCHES
#define MK_N_LAUNCHES 1
#endif
constexpr int N_PHASES = 14;
#ifndef DUP_MASK
#define DUP_MASK 0u
#endif

constexpr size_t MiB = 1u << 20;
constexpr size_t WS_WDOWN = 1 * MiB, WS_WUP = 23 * MiB, WS_HN = 67 * MiB, WS_PP = 99 * MiB, WS_WGATE = 131 * MiB, WS_WPLE = 139 * MiB, WS_WPOOL = 140 * MiB;
constexpr size_t WS_UP = 141 * MiB;
constexpr size_t WS_WIN = 141 * MiB, WS_WOUT = 156 * MiB, WS_PROJ = 164 * MiB, WS_YCAT = 224 * MiB, WS_MIXED = 256 * MiB, WS_XST = 272 * MiB;
constexpr size_t WS_BM = 288 * MiB, WS_BMT = 292 * MiB, WS_CM = 296 * MiB, WS_TAB = 300 * MiB, WS_DTRAW = 302 * MiB, WS_HIN = 304 * MiB, WS_PBF = 336 * MiB;
constexpr size_t WS_STATES = 67 * MiB;
constexpr size_t WS_MIX = 256 * MiB;
constexpr size_t WS_FF = 23 * MiB;
constexpr size_t WS_ACT = 141 * MiB;
constexpr size_t WS_EDGE = 229 * MiB;
constexpr size_t WS_HN3 = 234 * MiB, WS_T = 266 * MiB;
constexpr size_t WS_TABW = 340 * MiB;
constexpr size_t WS_END = 341 * MiB;

constexpr int LDS_BYTES = 155648;
constexpr int LDS_XCH = 131072, LDS_MISC = 155648 - 256;
constexpr int CW_BAR = 4096;
constexpr size_t CTL_ZERO_BYTES = 65536;

#define LAS __attribute__((address_space(3)))
typedef unsigned short bf16;
typedef unsigned v4u __attribute__((ext_vector_type(4)));
typedef unsigned v2u __attribute__((ext_vector_type(2)));
typedef float f32x4 __attribute__((ext_vector_type(4)));
typedef float f32x2 __attribute__((ext_vector_type(2)));
typedef short bf16x8 __attribute__((ext_vector_type(8)));
#define LDS_WAIT() asm volatile("s_waitcnt lgkmcnt(0)" ::: "memory")
__device__ __forceinline__ unsigned f2bf(float f) { unsigned u = __builtin_bit_cast(unsigned, f); return (u + 0x7fffu + ((u >> 16) & 1u)) >> 16; }
__device__ __forceinline__ unsigned pk2(float lo, float hi) { return f2bf(lo) | (f2bf(hi) << 16); }
__device__ __forceinline__ float bf2f(bf16 b) { return __uint_as_float((unsigned)b << 16); }
__device__ __forceinline__ float bflo(unsigned u) { return __uint_as_float(u << 16); }
__device__ __forceinline__ float bfhi(unsigned u) { return __uint_as_float(u & 0xffff0000u); }
__device__ __forceinline__ float wave_sum(float v) {
#pragma unroll
    for (int o = 1; o < 64; o <<= 1) v += __shfl_xor(v, o);
    return v;
}
__device__ __forceinline__ float dot4(f32x4 a) { return (a.x * a.x + a.y * a.y) + (a.z * a.z + a.w * a.w); }

#define XB_TMO      128
#define XB_XCNT(j)  (256  + 64 * (j))
#define XB_XSUB(j)  (1280 + 64 * (j))
#define XB_XGEN(j)  (2304 + 64 * (j))
#define XB_TOP      3328
#define XB_TOPGEN   3392
#define XCD_BAR_WORDS 3456
#define XB_SPIN_CAP (1u << 18)

__device__ __forceinline__ unsigned xb_ld(unsigned* p)              { return __hip_atomic_load(p, __ATOMIC_RELAXED, __HIP_MEMORY_SCOPE_AGENT); }
__device__ __forceinline__ unsigned xb_add(unsigned* p, unsigned v) { return __hip_atomic_fetch_add(p, v, __ATOMIC_RELAXED, __HIP_MEMORY_SCOPE_AGENT); }
__device__ __forceinline__ unsigned xb_xcc_id() { return (unsigned)__builtin_amdgcn_s_getreg((3 << 11) | 20) & 0xFu; }
#define XB_SPIN(cond, bar) do { unsigned _sp = 0; while (cond) { __builtin_amdgcn_s_sleep(1); \
    if ((++_sp & 255u) == 0u) { if (xb_ld(&(bar)[XB_TMO])) break; if (_sp > XB_SPIN_CAP) { atomicAdd(&(bar)[XB_TMO], 1u); break; } } } } while (0)

struct XcdBarrier {
    unsigned* bar; unsigned x;
    volatile LAS unsigned* st;
};

__device__ __forceinline__ XcdBarrier xcd_barrier_post(unsigned* bar, volatile LAS unsigned* st) {
    XcdBarrier b; b.bar = bar; b.x = xb_xcc_id(); b.st = st;
    if (threadIdx.x == 0) (void)xb_add(&bar[XB_XCNT(b.x)], 1u);
    return b;
}
__device__ __forceinline__ void xcd_barrier_complete(unsigned* bar, unsigned x, unsigned& nloc, unsigned& nx) {
    const unsigned G = gridDim.x * gridDim.y * gridDim.z;
    unsigned sum, cnt, mine, sp = 0u;
    for (;;) {
        sum = 0u; cnt = 0u; mine = 0u;
#pragma unroll
        for (unsigned j = 0; j < 16; ++j) { const unsigned c = xb_ld(&bar[XB_XCNT(j)]); sum += c; cnt += (c > 0u) ? 1u : 0u; mine = (j == x) ? c : mine; }
        if (sum == G) break;
        __builtin_amdgcn_s_sleep(1);
        if ((++sp & 255u) == 0u) { if (xb_ld(&bar[XB_TMO])) break; if (sp > XB_SPIN_CAP) { atomicAdd(&bar[XB_TMO], 1u); break; } }
    }
    nloc = mine > 0u ? mine : 1u; nx = cnt > 0u ? cnt : 1u;
}

__device__ __forceinline__ void xcd_barrier(const XcdBarrier& b) {
    asm volatile("s_waitcnt vmcnt(0)" ::: "memory");
    __syncthreads();
    if (threadIdx.x == 0) {
        unsigned* bar = b.bar;
        __builtin_amdgcn_s_waitcnt(0);
        unsigned nloc = b.st[0], nx = b.st[1];
        if (nloc == 0u) { xcd_barrier_complete(bar, b.x, nloc, nx); b.st[0] = nloc; b.st[1] = nx; }
        const unsigned old = xb_add(&bar[XB_XSUB(b.x)], 1u);
        const unsigned gen = old / nloc;
        if (old + 1u == (gen + 1u) * nloc) {
            __builtin_amdgcn_fence(__ATOMIC_RELEASE, "agent");
            asm volatile("s_waitcnt vmcnt(0)" ::: "memory");
            const unsigned og = xb_add(&bar[XB_TOP], 1u);
            const unsigned tg = og / nx;
            if (og + 1u == (tg + 1u) * nx) xb_add(&bar[XB_TOPGEN], 1u);
            else XB_SPIN(xb_ld(&bar[XB_TOPGEN]) == tg, bar);
            __builtin_amdgcn_fence(__ATOMIC_ACQUIRE, "agent");
            xb_add(&bar[XB_XGEN(b.x)], 1u);
            asm volatile("s_waitcnt vmcnt(0)" ::: "memory");
        } else {
            XB_SPIN(xb_ld(&bar[XB_XGEN(b.x)]) == gen, bar);
            __builtin_amdgcn_fence(__ATOMIC_ACQUIRE, "agent");
            asm volatile("s_waitcnt vmcnt(0)" ::: "memory");
        }
    }
    __syncthreads();
}

struct Ptrs {
    const float *x, *p, *mix_norm_pre, *mix_norm_post, *w_in, *ssd_conv_w, *ssd_conv_b, *ssd_dt_bias, *ssd_a_log, *ssd_d, *ssd_norm, *pool_w, *pool_scale, *w_out,
        *ffn_norm_pre, *ffn_norm_post, *w_ffn_up, *ffn_conv_w, *ffn_conv_b, *w_ffn_down, *ple_norm_pre, *w_ple_gate, *w_ple, *ple_norm_post;
    float* out; unsigned char* ws;
};

__device__ __forceinline__ void p0_transpose_item(const float* W, int N, bf16* WT, int ldt, int drow0, int k0, int n0, const float* scale, LAS float* scr, int lane) {
    float ld[32];
#pragma unroll
    for (int i = 0; i < 32; ++i) { const int kk = 2 * i + (lane >> 5); ld[i] = W[(size_t)(k0 + kk) * N + n0 + (lane & 31)]; }
#pragma unroll
    for (int i = 0; i < 32; ++i) { const int kk = 2 * i + (lane >> 5); scr[kk * 33 + (lane & 31)] = ld[i]; }
    LDS_WAIT(); asm volatile("" ::: "memory");
    const int c = lane & 7;
#pragma unroll
    for (int j = 0; j < 4; ++j) { const int n = (lane >> 3) + 8 * j; const LAS float* s = scr + (8 * c) * 33 + n; const float sc = scale ? scale[n0 + n] : 1.f;
        v4u o; o.x = pk2(s[0 * 33] * sc, s[1 * 33] * sc); o.y = pk2(s[2 * 33] * sc, s[3 * 33] * sc); o.z = pk2(s[4 * 33] * sc, s[5 * 33] * sc); o.w = pk2(s[6 * 33] * sc, s[7 * 33] * sc);
        *(v4u*)(WT + (size_t)(drow0 + n) * ldt + k0 + 8 * c) = o; }
    LDS_WAIT(); asm volatile("" ::: "memory");
}
__device__ __forceinline__ void rms_row_to_bf16(const float* xrow, const float* g, bf16* orow, int lane) {
    const f32x4* xr = (const f32x4*)xrow + lane; f32x4 v[8]; float s = 0.f;
#pragma unroll
    for (int j = 0; j < 8; ++j) { v[j] = xr[64 * j]; s += dot4(v[j]); }
    const float r = 1.f / sqrtf(wave_sum(s) * (1.f / DM) + EPS);
#pragma unroll
    for (int j = 0; j < 8; ++j) { const f32x4 gv = ((const f32x4*)g)[lane + 64 * j]; const f32x4 o = v[j] * r * gv;
        *(v2u*)(orow + (size_t)(lane + 64 * j) * 4) = (v2u){pk2(o.x, o.y), pk2(o.z, o.w)}; }
}
__device__ __forceinline__ void p0_prologue(const Ptrs& P, LAS unsigned char* lds, int G, int wave, int lane) {
    LAS float* scr = (LAS float*)(lds + wave * 16384);
    const int gw = blockIdx.x * NWAVES + wave, NGW = G * NWAVES;
    bf16* w_inT = (bf16*)(P.ws + WS_WIN); bf16* w_outT = (bf16*)(P.ws + WS_WOUT); bf16* w_upT = (bf16*)(P.ws + WS_WUP); bf16* w_downT = (bf16*)(P.ws + WS_WDOWN);
    bf16* w_gateT = (bf16*)(P.ws + WS_WGATE); bf16* w_pleT = (bf16*)(P.ws + WS_WPLE); bf16* w_poolT = (bf16*)(P.ws + WS_WPOOL);
    constexpr int I_IN = 32 * 113, I_OUT = 32 * 64, I_UP = 32 * 352, I_DOWN = 88 * 64, I_GATE = 32 * 64, I_PLE = 4 * 64, I_POOL = 4 * 32;
    constexpr int NITEMS = I_IN + I_OUT + I_UP + I_DOWN + I_GATE + I_PLE + I_POOL;
    for (int it = gw; it < NITEMS; it += NGW) {
        int r = it;
        if (r < I_IN) { const int kb = r / 113, nb = r % 113; const int drow = nb < 80 ? nb * 32 : (nb == 80 ? 3584 : (nb - 1) * 32);
            p0_transpose_item(P.w_in, 3616, w_inT, DM, drow, kb * 64, nb * 32, nullptr, scr, lane); continue; } r -= I_IN;
        if (r < I_OUT) { const int kb = r / 64, nb = r % 64; p0_transpose_item(P.w_out, DM, w_outT, DM, nb * 32, kb * 64, nb * 32, nullptr, scr, lane); continue; } r -= I_OUT;
        if (r < I_UP) { const int kb = r / 352, nb = r % 352; const int isv = nb >= 176, c0 = (nb - isv * 176) * 32; const int drow = (c0 >> 7) * 256 + isv * 128 + (c0 & 127);
            p0_transpose_item(P.w_ffn_up, 2 * DFF, w_upT, DM, drow, kb * 64, nb * 32, nullptr, scr, lane); continue; } r -= I_UP;
        if (r < I_DOWN) { const int kb = r / 64, nb = r % 64; p0_transpose_item(P.w_ffn_down, DM, w_downT, DFF, nb * 32, kb * 64, nb * 32, nullptr, scr, lane); continue; } r -= I_DOWN;
        if (r < I_GATE) { const int kb = r / 64, nb = r % 64; p0_transpose_item(P.w_ple_gate, DM, w_gateT, DM, nb * 32, kb * 64, nb * 32, nullptr, scr, lane); continue; } r -= I_GATE;
        if (r < I_PLE) { const int kb = r / 64, nb = r % 64; p0_transpose_item(P.w_ple, DM, w_pleT, DPLE, nb * 32, kb * 64, nb * 32, nullptr, scr, lane); continue; } r -= I_PLE;
        { const int gi = r / 32, q = r % 32, kb = q / 8, nb = q % 8;
          p0_transpose_item(P.pool_w + (size_t)gi * 65536, 256, w_poolT + (size_t)gi * 65536, 256, nb * 32, kb * 64, nb * 32, P.pool_scale + gi * 256, scr, lane); }
    }
    { v4u* zp = (v4u*)(w_inT + (size_t)3616 * DM); const int nz = 224 * DM * 2 / 16;
      for (int i = gw * 64 + lane; i < nz; i += NGW * 64) zp[i] = (v4u){0u, 0u, 0u, 0u}; }
    { const f32x4* ps = (const f32x4*)P.p; v2u* pd = (v2u*)(P.ws + WS_PBF); const int np = L * DPLE / 4;
      for (int i = gw * 64 + lane; i < np; i += NGW * 64) { const f32x4 v = ps[i]; pd[i] = (v2u){pk2(v.x, v.y), pk2(v.z, v.w)}; } }
    bf16* hn = (bf16*)(P.ws + WS_HN);
    for (int m = gw; m < L; m += NGW) rms_row_to_bf16(P.x + (size_t)m * DM, P.mix_norm_pre, hn + (size_t)m * DM, lane);
}

__device__ __forceinline__ float softplus_f(float x) { return fmaxf(x, 0.f) + log1pf(__expf(-fabsf(x))); }
template <int K> __device__ __forceinline__ void pool_item(const bf16* src  , bf16* dst  , int t0) {
    constexpr int H = K / 2, NR = 8 + K - 1;
    v4u rows[NR];
#pragma unroll
    for (int r = 0; r < NR; ++r) { const int t = t0 - H + r; rows[r] = (t >= 0 && t < L) ? *(const v4u*)(src + (size_t)t * NPROJ) : (v4u){0u, 0u, 0u, 0u}; }
    float inv[8];
#pragma unroll
    for (int i = 0; i < 8; ++i) { const int t = t0 + i; const int lo = t - H > 0 ? t - H : 0, hi = t + H < L ? t + H : L; inv[i] = 1.f / (float)(hi - lo); }
    unsigned ow[8][4];
#pragma unroll
    for (int w = 0; w < 4; ++w) { float vl[NR], vh[NR];
#pragma unroll
        for (int r = 0; r < NR; ++r) { const unsigned u = rows[r][w]; vl[r] = bflo(u); vh[r] = bfhi(u); }
#pragma unroll
        for (int i = 0; i < 8; ++i) { float sl = 0.f, sh = 0.f;
#pragma unroll
            for (int r = 0; r < K; ++r) { sl += vl[i + r]; sh += vh[i + r]; }
            ow[i][w] = pk2(sl * inv[i] - vl[i + H], sh * inv[i] - vh[i + H]); } }
#pragma unroll
    for (int i = 0; i < 8; ++i) *(v4u*)(dst + (size_t)(t0 + i) * 1024) = (v4u){ow[i][0], ow[i][1], ow[i][2], ow[i][3]};
}
__device__ __forceinline__ void p2_phase(const Ptrs& P, int G, int wave, int lane) {
    const int gw = blockIdx.x * NWAVES + wave, NGW = G * NWAVES;
    const bf16* proj = (const bf16*)(P.ws + WS_PROJ); const float* dtraw = (const float*)(P.ws + WS_DTRAW); float* tab = (float*)(P.ws + WS_TAB); float* tabw = (float*)(P.ws + WS_TABW);
    bf16* xsT = (bf16*)(P.ws + WS_XST); bf16* Bm = (bf16*)(P.ws + WS_BM); bf16* BmT = (bf16*)(P.ws + WS_BMT); bf16* Cm = (bf16*)(P.ws + WS_CM); bf16* mixed = (bf16*)(P.ws + WS_MIXED);
    for (int id = gw; id < NCH * 2 * NH; id += NGW) {
        const int c = id >> 5, dir = (id >> 4) & 1, h = id & 15;
        const float bias = P.ssd_dt_bias[dir * NH + h], a = -__expf(P.ssd_a_log[dir * NH + h]);
        const int i0 = 2 * lane, i1 = 2 * lane + 1, l0 = dir ? 127 - i0 : i0, l1 = dir ? 127 - i1 : i1;
        const float dt0 = softplus_f(dtraw[(size_t)(c * 128 + l0) * 32 + dir * NH + h] + bias), dt1 = softplus_f(dtraw[(size_t)(c * 128 + l1) * 32 + dir * NH + h] + bias);
        const float da0 = dt0 * a, da1 = dt1 * a; float s = da0 + da1;
#pragma unroll
        for (int o = 1; o < 64; o <<= 1) { const float t = __shfl_up(s, o); if (lane >= o) s += t; }
        const float excl = s - (da0 + da1);
        float* ta = tab + ((size_t)(dir * NCH + c) * NH + h) * 128; float* td = tab + ((size_t)((2 + dir) * NCH + c) * NH + h) * 128;
        ta[l0] = excl + da0; ta[l1] = s; td[l0] = dt0; td[l1] = dt1;
        const float tot = __shfl(s, 63); float* tw = tabw + ((size_t)(dir * NCH + c) * NH + h) * 128;
        tw[l0] = dt0 * __expf(tot - (excl + da0)); tw[l1] = dt1 * __expf(tot - s);
    }
    for (int it = gw; it < 1024 * 3; it += NGW) {
        const int tb = it / 3, cs = it % 3, t0 = tb * 8, ch = cs * 512 + lane * 8;
        const bf16* src = proj + 1024 + ch; v4u rows[12];
#pragma unroll
        for (int r = 0; r < 12; ++r) { const int t = t0 - 2 + r; rows[r] = (t >= 0 && t < L) ? *(const v4u*)(src + (size_t)t * NPROJ) : (v4u){0u, 0u, 0u, 0u}; }
        unsigned oc[8][4], ot[8][4];
#pragma unroll
        for (int w = 0; w < 4; ++w) {
            float wl[5], wh[5];
#pragma unroll
            for (int j = 0; j < 5; ++j) { const f32x2 wv = *(const f32x2*)(P.ssd_conv_w + j * 1536 + ch + 2 * w); wl[j] = wv.x; wh[j] = wv.y; }
            const f32x2 bv = *(const f32x2*)(P.ssd_conv_b + ch + 2 * w);
            float vl[12], vh[12], fl[8], fh[8];
#pragma unroll
            for (int r = 0; r < 12; ++r) { const unsigned u = rows[r][w]; vl[r] = bflo(u); vh[r] = bfhi(u); }
#pragma unroll
            for (int i = 0; i < 8; ++i) { float al = bv.x, ah = bv.y;
#pragma unroll
                for (int j = 0; j < 5; ++j) { al += wl[j] * vl[i + j]; ah += wh[j] * vh[i + j]; }
                fl[i] = al / (1.f + __expf(-al)); fh[i] = ah / (1.f + __expf(-ah)); ot[i][w] = pk2(fl[i], fh[i]); }
#pragma unroll
            for (int q = 0; q < 4; ++q) { oc[2 * w][q] = pk2(fl[2 * q], fl[2 * q + 1]); oc[2 * w + 1][q] = pk2(fh[2 * q], fh[2 * q + 1]); }
        }
        const int c = t0 >> 7, l0 = t0 & 127;
        if (cs < 2) {
#pragma unroll
            for (int e = 0; e < 8; ++e) { const int che = ch + e; *(v4u*)(xsT + ((size_t)((c * NH + (che >> 6)) * 64 + (che & 63))) * 128 + l0) = (v4u){oc[e][0], oc[e][1], oc[e][2], oc[e][3]}; }
        } else if (lane < 32) {
            const int gn0 = lane * 8;
#pragma unroll
            for (int e = 0; e < 8; ++e) { const int gn = gn0 + e; *(v4u*)(BmT + ((size_t)((c * 2 + (gn >> 7)) * 128 + (gn & 127))) * 128 + l0) = (v4u){oc[e][0], oc[e][1], oc[e][2], oc[e][3]}; }
#pragma unroll
            for (int i = 0; i < 8; ++i) *(v4u*)(Bm + (size_t)(t0 + i) * 256 + gn0) = (v4u){ot[i][0], ot[i][1], ot[i][2], ot[i][3]};
        } else {
            const int cn0 = (lane - 32) * 8;
#pragma unroll
            for (int i = 0; i < 8; ++i) *(v4u*)(Cm + (size_t)(t0 + i) * 256 + cn0) = (v4u){ot[i][0], ot[i][1], ot[i][2], ot[i][3]};
        }
    }
    for (int it = gw; it < 512 * 4; it += NGW) {
        const int tb = it >> 2, gi = it & 3, t0 = tb * 16 + (lane >> 5) * 8, ch = gi * 256 + (lane & 31) * 8;
        const bf16* src = proj + 2560 + ch; bf16* dst = mixed + ch;
        if (gi == 0) pool_item<2>(src, dst, t0); else if (gi == 1) pool_item<4>(src, dst, t0); else if (gi == 2) pool_item<8>(src, dst, t0); else pool_item<16>(src, dst, t0);
    }
}

__device__ __forceinline__ void p3_unit(const Ptrs& P, LAS unsigned char* lds, int c, int g, int dir, int tid, int wave, int lane) {
    const int fr = lane & 15, fq = lane >> 4, h = g * 8 + wave;
    const float* tw = (const float*)(P.ws + WS_TABW) + ((size_t)(dir * NCH + c) * NH + h) * 128;
    const bf16* xh = (const bf16*)(P.ws + WS_XST) + ((size_t)(c * NH + h) * 64) * 128; const bf16* bt = (const bf16*)(P.ws + WS_BMT) + ((size_t)(c * 2 + g) * 128) * 128;
    float* so = (float*)(P.ws + WS_STATES) + ((size_t)((dir * NCH + c) * NH + h)) * 64 * 128;
    __syncthreads();
#pragma unroll
    for (int k = 0; k < 4; ++k) { const int q = tid + 512 * k, row = q >> 4, c16 = q & 15; *(LAS v4u*)(lds + row * 272 + c16 * 16) = *(const v4u*)(bt + (size_t)row * 128 + c16 * 8); }
    bf16x8 Af[4][4];
#pragma unroll
    for (int kk = 0; kk < 4; ++kk) { const int lb = kk * 32 + fq * 8; const f32x4 w0 = *(const f32x4*)(tw + lb), w1 = *(const f32x4*)(tw + lb + 4);
#pragma unroll
        for (int mt = 0; mt < 4; ++mt) { const v4u raw = *(const v4u*)(xh + (size_t)(mt * 16 + fr) * 128 + lb);
            v4u sc; sc.x = pk2(bflo(raw.x) * w0[0], bfhi(raw.x) * w0[1]); sc.y = pk2(bflo(raw.y) * w0[2], bfhi(raw.y) * w0[3]);
            sc.z = pk2(bflo(raw.z) * w1[0], bfhi(raw.z) * w1[1]); sc.w = pk2(bflo(raw.w) * w1[2], bfhi(raw.w) * w1[3]);
            Af[kk][mt] = __builtin_bit_cast(bf16x8, sc); } }
    __syncthreads();
#pragma unroll
    for (int nh = 0; nh < 2; ++nh) {
        f32x4 acc[4][4];
#pragma unroll
        for (int mt = 0; mt < 4; ++mt)
#pragma unroll
            for (int nt = 0; nt < 4; ++nt) acc[mt][nt] = (f32x4){0.f, 0.f, 0.f, 0.f};
#pragma unroll
        for (int kk = 0; kk < 4; ++kk)
#pragma unroll
            for (int nt = 0; nt < 4; ++nt) { const bf16x8 Bf = *(const LAS bf16x8*)(lds + (nh * 64 + nt * 16 + fr) * 272 + (kk * 32 + fq * 8) * 2);
#pragma unroll
                for (int mt = 0; mt < 4; ++mt) acc[mt][nt] = __builtin_amdgcn_mfma_f32_16x16x32_bf16(Bf, Af[kk][mt], acc[mt][nt], 0, 0, 0); }
#pragma unroll
        for (int mt = 0; mt < 4; ++mt)
#pragma unroll
            for (int nt = 0; nt < 4; ++nt) *(f32x4*)(so + (size_t)(mt * 16 + fr) * 128 + nh * 64 + nt * 16 + fq * 4) = acc[mt][nt];
    }
}

__device__ __forceinline__ void p4_phase(const Ptrs& P, int G) {
    const float* tab = (const float*)(P.ws + WS_TAB); const float* states = (const float*)(P.ws + WS_STATES); bf16* hin = (bf16*)(P.ws + WS_HIN);
    for (int e = blockIdx.x * 512 + threadIdx.x; e < 2 * NH * 64 * 64; e += G * 512) {
        const int n2 = e & 63, p = (e >> 6) & 63, h = (e >> 12) & 15, dir = e >> 16;
        const size_t eo = (size_t)p * 128 + 2 * n2, cstride = (size_t)NH * 64 * 128;
        const float* sb = states + ((size_t)(dir * NCH) * NH + h) * 64 * 128 + eo; bf16* hb = hin + ((size_t)(dir * NCH) * NH + h) * 64 * 128 + eo;
        const float* ta = tab + ((size_t)(dir * NCH) * NH + h) * 128 + (dir ? 0 : 127);
        f32x2 st = (f32x2){0.f, 0.f};
#pragma unroll 1
        for (int i0 = 0; i0 < NCH; i0 += 8) {
            f32x2 sv[8]; float cd[8];
#pragma unroll
            for (int j = 0; j < 8; ++j) { const int c = dir ? NCH - 1 - (i0 + j) : i0 + j; sv[j] = *(const f32x2*)(sb + (size_t)c * cstride); cd[j] = ta[(size_t)c * NH * 128]; }
#pragma unroll
            for (int j = 0; j < 8; ++j) { const int c = dir ? NCH - 1 - (i0 + j) : i0 + j;
                *(unsigned*)(hb + (size_t)c * cstride) = pk2(st.x, st.y);
                const float d = __expf(cd[j]); st = st * d + sv[j]; }
        }
    }
}

constexpr int P5_PITCH = 272, P5_MAT = 64 * P5_PITCH, P5_STAGE = 16384, P5_Q = P5_STAGE + 6 * P5_MAT;
__device__ __forceinline__ void p5_ssd_unit(const Ptrs& P, LAS unsigned char* lds, int c, int g, int rh, int tid, int wave, int lane) {
    const int fr = lane & 15, fq = lane >> 4, rt = wave & 3, hs = wave >> 2, grt = rh * 4 + rt;
    const float* tab = (const float*)(P.ws + WS_TAB); const bf16* xsT = (const bf16*)(P.ws + WS_XST); const bf16* Bm = (const bf16*)(P.ws + WS_BM); const bf16* Cm = (const bf16*)(P.ws + WS_CM);
    const bf16* hin = (const bf16*)(P.ws + WS_HIN); const bf16* proj = (const bf16*)(P.ws + WS_PROJ); bf16* ycat = (bf16*)(P.ws + WS_YCAT);
    LAS float* T = (LAS float*)lds;
    LAS unsigned char* SB = lds + P5_STAGE;
    LAS float* Q = (LAS float*)(lds + P5_Q);
    const int t0 = c * 128, lrow = 64 * rh + 16 * rt + fr;
    const int srow0 = tid >> 4, scol = tid & 15;
    v4u R[12];
#define P5_LOAD(i) do { _Pragma("unroll") for (int k = 0; k < 12; ++k) { const int mi = k >> 1, hsel = mi / 3, mat = mi % 3, row = srow0 + 32 * (k & 1), h = g * 8 + hsel * 4 + (i); \
        const bf16* src = (mat == 0) ? xsT + ((size_t)(c * NH + h) * 64 + row) * 128 : hin + ((size_t)(((mat - 1) * NCH + c) * NH + h) * 64 + row) * 128; \
        R[k] = *(const v4u*)(src + scol * 8); } } while (0)
#define P5_STORE() do { _Pragma("unroll") for (int k = 0; k < 12; ++k) { const int mi = k >> 1, row = srow0 + 32 * (k & 1); *(LAS v4u*)(SB + mi * P5_MAT + row * P5_PITCH + scol * 16) = R[k]; } } while (0)
    __syncthreads();
    for (int idx = tid; idx < 4 * 8 * 128; idx += 512) { const int which = idx >> 10, hh = (idx >> 7) & 7, l = idx & 127; T[idx] = tab[((size_t)(which * NCH + c) * NH + g * 8 + hh) * 128 + l]; }
    bf16x8 Cf[4];
#pragma unroll
    for (int kk = 0; kk < 4; ++kk) Cf[kk] = *(const bf16x8*)(Cm + (size_t)(t0 + lrow) * 256 + g * 128 + kk * 32 + fq * 8);
    f32x4 cb[8];
#pragma unroll
    for (int st = 0; st < 8; ++st) { cb[st] = (f32x4){0.f, 0.f, 0.f, 0.f};
#pragma unroll
        for (int kk = 0; kk < 4; ++kk) { const bf16x8 Bf = *(const bf16x8*)(Bm + (size_t)(t0 + st * 16 + fr) * 256 + g * 128 + kk * 32 + fq * 8);
            cb[st] = __builtin_amdgcn_mfma_f32_16x16x32_bf16(Bf, Cf[kk], cb[st], 0, 0, 0); } }
    float sumsq = 0.f;
    bf16* yrow = ycat + (size_t)(t0 + lrow) * DM + g * 512 + hs * 256 + fq * 4;
#pragma unroll 1
    for (int i = 0; i < 4; ++i) {
        P5_LOAD(i);
        P5_STORE();
        __syncthreads();
        const int hh = hs * 4 + i, h = g * 8 + hh;
        const float alf = T[(0 * 8 + hh) * 128 + lrow], alb = T[(1 * 8 + hh) * 128 + lrow], dsk = P.ssd_d[h];
        bf16x8 Mf[4];
#pragma unroll
        for (int kk = 0; kk < 4; ++kk) { float mv[8];
#pragma unroll
            for (int hf = 0; hf < 2; ++hf) { const int st = 2 * kk + hf, s0 = st * 16 + fq * 4;
                if (st < grt) {
                    const f32x4 asf = *(const LAS f32x4*)(T + (0 * 8 + hh) * 128 + s0), dsf = *(const LAS f32x4*)(T + (2 * 8 + hh) * 128 + s0);
#pragma unroll
                    for (int r = 0; r < 4; ++r) mv[hf * 4 + r] = cb[st][r] * (__expf(fminf(alf - asf[r], 0.f)) * dsf[r]);
                } else if (st > grt) {
                    const f32x4 asb = *(const LAS f32x4*)(T + (1 * 8 + hh) * 128 + s0), dsb = *(const LAS f32x4*)(T + (3 * 8 + hh) * 128 + s0);
#pragma unroll
                    for (int r = 0; r < 4; ++r) mv[hf * 4 + r] = cb[st][r] * (__expf(fminf(alb - asb[r], 0.f)) * dsb[r]);
                } else {
                    const f32x4 asf = *(const LAS f32x4*)(T + (0 * 8 + hh) * 128 + s0), asb = *(const LAS f32x4*)(T + (1 * 8 + hh) * 128 + s0);
                    const f32x4 dsf = *(const LAS f32x4*)(T + (2 * 8 + hh) * 128 + s0), dsb = *(const LAS f32x4*)(T + (3 * 8 + hh) * 128 + s0);
#pragma unroll
                    for (int r = 0; r < 4; ++r) { const int s = s0 + r;
                        const float vf = (s <= lrow) ? __expf(fminf(alf - asf[r], 0.f)) * dsf[r] : 0.f;
                        const float vb = (s >= lrow) ? __expf(fminf(alb - asb[r], 0.f)) * dsb[r] : 0.f;
                        mv[hf * 4 + r] = cb[st][r] * (vf + vb) + ((s == lrow) ? dsk : 0.f); } } }
            const v4u pk = (v4u){pk2(mv[0], mv[1]), pk2(mv[2], mv[3]), pk2(mv[4], mv[5]), pk2(mv[6], mv[7])};
            Mf[kk] = __builtin_bit_cast(bf16x8, pk); }
        f32x4 accY[4], accF[4], accB[4];
#pragma unroll
        for (int pt = 0; pt < 4; ++pt) { accY[pt] = (f32x4){0.f, 0.f, 0.f, 0.f}; accF[pt] = accY[pt]; accB[pt] = accY[pt]; }
        const LAS unsigned char* Sx = SB + (hs * 3 + 0) * P5_MAT; const LAS unsigned char* Sf = SB + (hs * 3 + 1) * P5_MAT; const LAS unsigned char* Sb = SB + (hs * 3 + 2) * P5_MAT;
#pragma unroll
        for (int kk = 0; kk < 4; ++kk)
#pragma unroll
            for (int pt = 0; pt < 4; ++pt) { const int ro = (pt * 16 + fr) * P5_PITCH;
                const v2u lo = *(const LAS v2u*)(Sx + ro + ((2 * kk) * 16 + fq * 4) * 2), hi = *(const LAS v2u*)(Sx + ro + ((2 * kk + 1) * 16 + fq * 4) * 2);
                const bf16x8 Xf = __builtin_bit_cast(bf16x8, ((v4u){lo.x, lo.y, hi.x, hi.y}));
                accY[pt] = __builtin_amdgcn_mfma_f32_16x16x32_bf16(Xf, Mf[kk], accY[pt], 0, 0, 0);
                const bf16x8 Hf = *(const LAS bf16x8*)(Sf + ro + (kk * 32 + fq * 8) * 2);
                accF[pt] = __builtin_amdgcn_mfma_f32_16x16x32_bf16(Hf, Cf[kk], accF[pt], 0, 0, 0);
                const bf16x8 Hb = *(const LAS bf16x8*)(Sb + ro + (kk * 32 + fq * 8) * 2);
                accB[pt] = __builtin_amdgcn_mfma_f32_16x16x32_bf16(Hb, Cf[kk], accB[pt], 0, 0, 0); }
        const float ef = __expf(alf), eb = __expf(alb);
#pragma unroll
        for (int pt = 0; pt < 4; ++pt) {
            const v2u zr = *(const v2u*)(proj + (size_t)(t0 + lrow) * NPROJ + h * 64 + pt * 16 + fq * 4);
            const float z[4] = {bflo(zr.x), bfhi(zr.x), bflo(zr.y), bfhi(zr.y)}; float y[4];
#pragma unroll
            for (int r = 0; r < 4; ++r) { y[r] = (accY[pt][r] + ef * accF[pt][r] + eb * accB[pt][r]) * (z[r] / (1.f + __expf(-z[r]))); sumsq += y[r] * y[r]; }
            *(v2u*)(yrow + i * 64 + pt * 16) = (v2u){pk2(y[0], y[1]), pk2(y[2], y[3])}; }
        __syncthreads();
    }
    sumsq += __shfl_xor(sumsq, 16); sumsq += __shfl_xor(sumsq, 32);
    if (fq == 0) Q[hs * 64 + rt * 16 + fr] = sumsq;
    __syncthreads();
    const float rs = 1.f / sqrtf((Q[rt * 16 + fr] + Q[64 + rt * 16 + fr]) * (1.f / 512.f) + EPS);
#pragma unroll
    for (int i = 0; i < 4; ++i)
#pragma unroll
        for (int pt = 0; pt < 4; ++pt) { bf16* yp = yrow + i * 64 + pt * 16; const v2u yv = *(const v2u*)yp; const int ch = g * 512 + (hs * 4 + i) * 64 + pt * 16 + fq * 4; const f32x4 nw = *(const f32x4*)(P.ssd_norm + ch);
            *(v2u*)yp = (v2u){pk2(bflo(yv.x) * rs * nw.x, bfhi(yv.x) * rs * nw.y), pk2(bflo(yv.y) * rs * nw.z, bfhi(yv.y) * rs * nw.w)}; }
#undef P5_LOAD
#undef P5_STORE
}

__device__ __forceinline__ void res_norm_norm_row(const float* m, const float* hin, float* hout, const float* g1, const float* g2, bf16* hn, int lane) {
    f32x4 v[8]; float s = 0.f;
#pragma unroll
    for (int j = 0; j < 8; ++j) { v[j] = ((const f32x4*)m)[lane + 64 * j]; s += dot4(v[j]); }
    const float r1 = 1.f / sqrtf(wave_sum(s) * (1.f / DM) + EPS); float s2 = 0.f;
#pragma unroll
    for (int j = 0; j < 8; ++j) { const f32x4 gv = ((const f32x4*)g1)[lane + 64 * j], hv = ((const f32x4*)hin)[lane + 64 * j]; v[j] = hv + v[j] * r1 * gv; s2 += dot4(v[j]); ((f32x4*)hout)[lane + 64 * j] = v[j]; }
    const float r2 = 1.f / sqrtf(wave_sum(s2) * (1.f / DM) + EPS);
#pragma unroll
    for (int j = 0; j < 8; ++j) { const f32x4 gv = ((const f32x4*)g2)[lane + 64 * j]; const f32x4 o = v[j] * r2 * gv; *(v2u*)(hn + (size_t)(lane + 64 * j) * 4) = (v2u){pk2(o.x, o.y), pk2(o.z, o.w)}; }
}
__device__ __forceinline__ void res_norm_row(const float* m, const float* hin, float* hout, const float* g1, int lane) {
    f32x4 v[8]; float s = 0.f;
#pragma unroll
    for (int j = 0; j < 8; ++j) { v[j] = ((const f32x4*)m)[lane + 64 * j]; s += dot4(v[j]); }
    const float r1 = 1.f / sqrtf(wave_sum(s) * (1.f / DM) + EPS);
#pragma unroll
    for (int j = 0; j < 8; ++j) { const f32x4 gv = ((const f32x4*)g1)[lane + 64 * j], hv = ((const f32x4*)hin)[lane + 64 * j]; ((f32x4*)hout)[lane + 64 * j] = hv + v[j] * r1 * gv; }
}

__device__ __forceinline__ float gelu_tanh(float x) { const float u = 0.7978845608028654f * (x + 0.044715f * x * x * x); const float t = 1.f - 2.f / (1.f + __expf(2.f * u)); return 0.5f * x * (1.f + t); }
__device__ __forceinline__ void p9_phase(const Ptrs& P, int G, int wave, int lane) {
    const int gw = blockIdx.x * NWAVES + wave, NGW = G * NWAVES;
    bf16* up = (bf16*)(P.ws + WS_UP);
    for (int it = gw; it < 1024 * 11; it += NGW) {
        const int tb = it / 11, cb = it % 11, t0 = tb * 8, ch = cb * 512 + lane * 8;
        float w0[8], w1[8], w2[8], bb[8];
#pragma unroll
        for (int q = 0; q < 2; ++q) { const f32x4 a = *(const f32x4*)(P.ffn_conv_w + ch + 4 * q), b = *(const f32x4*)(P.ffn_conv_w + DFF + ch + 4 * q), c = *(const f32x4*)(P.ffn_conv_w + 2 * DFF + ch + 4 * q), d = *(const f32x4*)(P.ffn_conv_b + ch + 4 * q);
#pragma unroll
            for (int e = 0; e < 4; ++e) { w0[4 * q + e] = a[e]; w1[4 * q + e] = b[e]; w2[4 * q + e] = c[e]; bb[4 * q + e] = d[e]; } }
        v4u prev, cur, nxt;
        prev = (t0 > 0) ? *(const v4u*)(up + (size_t)(t0 - 1) * (2 * DFF) + ch) : (v4u){0u, 0u, 0u, 0u};
        cur = *(const v4u*)(up + (size_t)t0 * (2 * DFF) + ch);
#pragma unroll
        for (int i = 0; i < 8; ++i) { const int t = t0 + i;
            nxt = (t + 1 < L) ? *(const v4u*)(up + (size_t)(t + 1) * (2 * DFF) + ch) : (v4u){0u, 0u, 0u, 0u};
            const v4u vv = *(const v4u*)(up + (size_t)t * (2 * DFF) + DFF + ch);
            const unsigned pw[4] = {prev.x, prev.y, prev.z, prev.w}, cw[4] = {cur.x, cur.y, cur.z, cur.w}, nw[4] = {nxt.x, nxt.y, nxt.z, nxt.w}, vw[4] = {vv.x, vv.y, vv.z, vv.w}; unsigned ow[4];
#pragma unroll
            for (int q = 0; q < 4; ++q) {
                const float g0 = bb[2 * q] + w0[2 * q] * bflo(pw[q]) + w1[2 * q] * bflo(cw[q]) + w2[2 * q] * bflo(nw[q]);
                const float g1 = bb[2 * q + 1] + w0[2 * q + 1] * bfhi(pw[q]) + w1[2 * q + 1] * bfhi(cw[q]) + w2[2 * q + 1] * bfhi(nw[q]);
                ow[q] = pk2(gelu_tanh(g0) * bflo(vw[q]), gelu_tanh(g1) * bfhi(vw[q])); }
            *(v4u*)(up + (size_t)t * (2 * DFF) + DFF + ch) = (v4u){ow[0], ow[1], ow[2], ow[3]};
            prev = cur; cur = nxt; }
    }
}

struct Args { Ptrs P; int ph_lo, ph_hi, coop, pad; };
__global__ void __launch_bounds__(NWAVES * 64, 2) fwd_kernel(Args args) {
    extern __shared__ __attribute__((aligned(16))) unsigned char lds_raw[];
    LAS unsigned char* lds = (LAS unsigned char*)lds_raw;
    const Ptrs& P = args.P;
    const int G = gridDim.x;
#define PH_VARS int tid_ = threadIdx.x; asm volatile("" : "+v"(tid_)); const int tid = tid_, lane = tid & 63, wave = __builtin_amdgcn_readfirstlane(tid >> 6), gw = blockIdx.x * NWAVES + wave, NGW = G * NWAVES; (void)tid; (void)lane; (void)gw; (void)NGW;
    const int lo = args.ph_lo, hi = args.ph_hi;
#define IN(k) (lo <= (k) && (k) < hi)
    volatile LAS unsigned* MISC = (volatile LAS unsigned*)(lds + LDS_MISC);
    if (threadIdx.x < 32) MISC[threadIdx.x] = 0u;
    __syncthreads();
    XcdBarrier bar; bar.bar = (unsigned*)P.ws + CW_BAR; bar.x = 0; bar.st = nullptr;
    if (args.coop) bar = xcd_barrier_post((unsigned*)P.ws + CW_BAR, MISC + 8);
    if (args.coop == 2) cg::this_grid().sync();
#define SEAM(k) do { if (IN(k) && IN((k) + 1)) { xcd_barrier(bar); } } while (0)
    unsigned char* ws = P.ws;
#define HN ((bf16*)(ws + WS_HN))

    if (IN(0)) { PH_VARS p0_prologue(P, lds, G, wave, lane); } SEAM(0);
    if (IN(1)) {
        pg8::Gemm g{HN, (const bf16*)(ws + WS_WIN), DM, DM, DM, 0}; pg8::StaticOrder S; S.init(L, NPROJ_PAD, G, (int)blockIdx.x);
        pg8::EpiProj E{(bf16*)(ws + WS_PROJ), (float*)(ws + WS_DTRAW)};
        pg8::gemm_phase<pg8::EpiProj, pg8::StaticOrder, true, true>(lds, g, S, E);
    } SEAM(1);
    if (IN(2)) { PH_VARS p2_phase(P, G, wave, lane); } SEAM(2);
    if (IN(3)) { PH_VARS for (int u = blockIdx.x; u < NCH * 4; u += G) p3_unit(P, lds, u >> 2, (u >> 1) & 1, u & 1, tid, wave, lane); } SEAM(3);
    if (IN(4)) { p4_phase(P, G); } SEAM(4);
    if (IN(5)) { PH_VARS
        for (int u = blockIdx.x; u < NCH * 4; u += G) p5_ssd_unit(P, lds, u >> 2, (u >> 1) & 1, u & 1, tid, wave, lane);
        __syncthreads();
        int k256 = 256; asm volatile("" : "+s"(k256));
        {
            pg8::Gemm g{(const bf16*)(ws + WS_MIXED), (const bf16*)(ws + WS_WPOOL), 1024, 256, k256, 256}; pg8::StaticOrder S; S.init(L, 1024, G, (int)blockIdx.x);
            pg8::EpiBf16 E{(bf16*)(ws + WS_YCAT) + 1024, DM};
            pg8::gemm_phase<pg8::EpiBf16, pg8::StaticOrder, true, true>(lds, g, S, E);
        }
        {
            pg8::Gemm g{(const bf16*)(ws + WS_PBF), (const bf16*)(ws + WS_WPLE), DPLE, DPLE, k256, 0}; pg8::StaticOrder S; S.init(L, DM, G, (int)blockIdx.x);
            pg8::EpiBf16 E{(bf16*)(ws + WS_PP), DM};
            pg8::gemm_phase<pg8::EpiBf16, pg8::StaticOrder, true, true>(lds, g, S, E);
        }
    } SEAM(5);
    if (IN(6)) {
        pg8::Gemm g{(const bf16*)(ws + WS_YCAT), (const bf16*)(ws + WS_WOUT), DM, DM, DM, 0}; pg8::StaticOrder S; S.init(L, DM, G, (int)blockIdx.x);
        pg8::EpiF32 E{(float*)(ws + WS_MIX), DM};
        pg8::gemm_phase<pg8::EpiF32, pg8::StaticOrder, true, true>(lds, g, S, E);
    } SEAM(6);
    if (IN(7)) { PH_VARS
        for (int m = gw; m < L; m += NGW) res_norm_norm_row((const float*)(ws + WS_MIX) + (size_t)m * DM, P.x + (size_t)m * DM, P.out + (size_t)m * DM, P.mix_norm_post, P.ffn_norm_pre, HN + (size_t)m * DM, lane);
    } SEAM(7);
    if (IN(8)) {
        pg8::Gemm g{HN, (const bf16*)(ws + WS_WUP), DM, DM, DM, 0}; pg8::StaticOrder S; S.init(L, 2 * DFF, G, (int)blockIdx.x);
        pg8::EpiGlu E{(bf16*)(ws + WS_ACT), (float*)(ws + WS_EDGE), P.ffn_conv_w, P.ffn_conv_b, lds + LDS_XCH};
        pg8::gemm_phase<pg8::EpiGlu, pg8::StaticOrder, true, true>(lds, g, S, E);
    } SEAM(8);
    if (IN(10)) { PH_VARS
        pg8::Gemm g{(const bf16*)(ws + WS_ACT), (const bf16*)(ws + WS_WDOWN), DFF, DFF, DFF, 0}; pg8::StaticOrder S; S.init(L, DM, G, (int)blockIdx.x);
        { pg8::Unit u0; if (S.next(0, u0)) { const int pm = u0.pm; const float* E = (const float*)(ws + WS_EDGE); bf16* act = (bf16*)(ws + WS_ACT); const float* Ec = E + (size_t)pm * 6 * DFF;
            for (int idx = tid; idx < 2 * DFF; idx += NWAVES * 64) { const int which = idx >= DFF, ch = idx - which * DFF; float prev, cur, next, val; int row;
                if (!which) { prev = pm > 0 ? E[((size_t)(pm - 1) * 6 + 3) * DFF + ch] : 0.f; cur = Ec[0 * DFF + ch]; next = Ec[1 * DFF + ch]; val = Ec[4 * DFF + ch]; row = 256 * pm; }
                else { prev = Ec[2 * DFF + ch]; cur = Ec[3 * DFF + ch]; next = pm < 31 ? E[((size_t)(pm + 1) * 6 + 0) * DFF + ch] : 0.f; val = Ec[5 * DFF + ch]; row = 256 * pm + 255; }
                const float a = P.ffn_conv_b[ch] + P.ffn_conv_w[ch] * prev + P.ffn_conv_w[DFF + ch] * cur + P.ffn_conv_w[2 * DFF + ch] * next;
                act[(size_t)row * DFF + ch] = (bf16)f2bf(pg8::gelu_tanh_f(a) * val); } }
          __builtin_amdgcn_fence(__ATOMIC_SEQ_CST, "agent"); __syncthreads(); }
        pg8::EpiF32 E{(float*)(ws + WS_FF), DM};
        pg8::gemm_phase<pg8::EpiF32, pg8::StaticOrder, true, true>(lds, g, S, E);
    } SEAM(10);
    if (IN(11)) { PH_VARS
        bf16* hn3 = (bf16*)(ws + WS_HN3);
        for (int m = gw; m < L; m += NGW) res_norm_norm_row((const float*)(ws + WS_FF) + (size_t)m * DM, P.out + (size_t)m * DM, P.out + (size_t)m * DM, P.ffn_norm_post, P.ple_norm_pre, hn3 + (size_t)m * DM, lane);
    } SEAM(11);
    if (IN(12)) {
        pg8::Gemm g{(const bf16*)(ws + WS_HN3), (const bf16*)(ws + WS_WGATE), DM, DM, DM, 0}; pg8::StaticOrder S; S.init(L, DM, G, (int)blockIdx.x);
        pg8::EpiGate E{(float*)(ws + WS_T), (const bf16*)(ws + WS_PP), DM};
        pg8::gemm_phase<pg8::EpiGate, pg8::StaticOrder, true, true>(lds, g, S, E);
    } SEAM(12);
    if (IN(13)) { PH_VARS
        for (int m = gw; m < L; m += NGW) res_norm_row((const float*)(ws + WS_T) + (size_t)m * DM, P.out + (size_t)m * DM, P.out + (size_t)m * DM, P.ple_norm_post, lane);
    }
#undef IN
#undef SEAM
}

extern "C" void kernel_launch(void* const* d_in, const int* in_sizes, int n_in, void* d_out, int out_size, void* d_ws, size_t ws_size, hipStream_t stream) {
    static int grid = 0;
    if (grid == 0) {
        if (n_in != 24 || in_sizes[0] != L * DM || out_size != L * DM || ws_size < WS_END) { fprintf(stderr, "kernel_launch: unexpected shapes / workspace (n_in %d, ws %zu, need %zu)\n", n_in, ws_size, (size_t)WS_END); grid = -1; return; }
        int dev = 0, cus = 0, per_cu = 0;
        hipGetDevice(&dev); hipDeviceGetAttribute(&cus, hipDeviceAttributeMultiprocessorCount, dev);
        if (hipFuncSetAttribute((const void*)fwd_kernel, hipFuncAttributeMaxDynamicSharedMemorySize, LDS_BYTES) != hipSuccess) { fprintf(stderr, "kernel_launch: hipFuncSetAttribute failed\n"); grid = -1; return; }
        if (hipOccupancyMaxActiveBlocksPerMultiprocessor(&per_cu, (const void*)fwd_kernel, NWAVES * 64, LDS_BYTES) != hipSuccess || per_cu < 1) { fprintf(stderr, "kernel_launch: occupancy query says %d\n", per_cu); per_cu = 1; }
        (void)hipGetLastError();
        grid = cus * 1;
    }
    if (grid < 0) return;
    Args a{};
    const float** pp = (const float**)&a.P;
    for (int i = 0; i < 24; ++i) pp[i] = (const float*)d_in[i];
    a.P.out = (float*)d_out; a.P.ws = (unsigned char*)d_ws;
#if MK_N_LAUNCHES == 1
    if (hipMemsetAsync(d_ws, 0, CTL_ZERO_BYTES, stream) != hipSuccess) { fprintf(stderr, "kernel_launch: memset of the barrier words failed\n"); return; }
    a.ph_lo = 0; a.ph_hi = N_PHASES; a.coop = 1;
    void* kargs[] = {&a};
    hipError_t e = hipLaunchCooperativeKernel((const void*)fwd_kernel, dim3(grid), dim3(NWAVES * 64), kargs, LDS_BYTES, stream);
    if (e != hipSuccess) fprintf(stderr, "cooperative launch failed: %s (grid %d)\n", hipGetErrorString(e), grid);
#else
    for (int li = 0; li < N_PHASES; ++li) { a.ph_lo = li; a.ph_hi = li + 1; a.coop = 0;
        for (int rep = 0; rep < 1 + (int)((DUP_MASK >> li) & 1u); ++rep) hipLaunchKernelGGL(fwd_kernel, dim3(grid), dim3(NWAVES * 64), LDS_BYTES, stream, a); }
#endif
}
```
